# Optimizing an MI355X kernel written in HIP

```python
import jax, jax.numpy as jnp
from jax import lax
import numpy as np

D_MODEL = 2048
BATCH = 4
SEQ = 2048
DEPTH = 1

HEAD_DIM = 64
ATTN_HEADS = D_MODEL // 128
KV_HEADS = ATTN_HEADS // 4
Q_DIM = ATTN_HEADS * HEAD_DIM
KV_DIM = KV_HEADS * HEAD_DIM
WINDOW = 128
ATTN_BLOCK = 128
ROPE_THETA = 10000.0
D_INNER = D_MODEL
SSM_HEAD_DIM = 64
SSM_HEADS = D_INNER // SSM_HEAD_DIM
SSM_GROUPS = 4
D_STATE = 128
CONV_WIDTH = 4
CHUNK = 128
CONV_DIM = D_INNER + 2 * SSM_GROUPS * D_STATE
FFN_HIDDEN = -(-(8 * D_MODEL) // (3 * 256)) * 256
PLE_DIM = 256
IN_DIM = Q_DIM + 2 * KV_DIM + D_INNER + CONV_DIM + SSM_HEADS + 2 * D_MODEL
NORM_EPS = 1e-6
SSM_NORM_EPS = 1e-5

kernel_name = "hybrid_swa_sink_ssd_gated_block"


def rmsnorm(x, g, eps=NORM_EPS):
    xf = x.astype(jnp.float32)
    y = xf * lax.rsqrt(jnp.mean(xf * xf, axis=-1, keepdims=True) + eps)
    return (y * g.astype(jnp.float32)).astype(x.dtype)


def apply_rope(t, positions):
    half = HEAD_DIM // 2
    inv_freq = ROPE_THETA ** (-jnp.arange(half, dtype=jnp.float32) * 2.0 / HEAD_DIM)
    ang = positions.astype(jnp.float32)[..., None] * inv_freq
    cos, sin = jnp.cos(ang)[:, :, None, :], jnp.sin(ang)[:, :, None, :]
    t1, t2 = t[..., :half], t[..., half:]
    return jnp.concatenate([t1 * cos - t2 * sin, t2 * cos + t1 * sin], axis=-1)


def sliding_window_sink_attention(q, k, v, sinks):
    b, s = q.shape[0], q.shape[1]
    nb = s // ATTN_BLOCK
    grp = ATTN_HEADS // KV_HEADS
    qb = q.reshape(b, nb, ATTN_BLOCK, KV_HEADS, grp, HEAD_DIM)

    def banded(t):
        tb = t.reshape(b, nb, ATTN_BLOCK, KV_HEADS, HEAD_DIM)
        prev = jnp.pad(tb, ((0, 0), (1, 0), (0, 0), (0, 0), (0, 0)))[:, :-1]
        return jnp.concatenate([prev, tb], axis=2)

    kw, vw = banded(k), banded(v)
    scores = jnp.einsum('bnqhgd,bnkhd->bnhgqk', qb, kw) * (HEAD_DIM ** -0.5)
    qi = jnp.arange(ATTN_BLOCK)[:, None] + ATTN_BLOCK
    kj = jnp.arange(2 * ATTN_BLOCK)[None, :]
    dist = qi - kj
    key_pos = (jnp.arange(nb) * ATTN_BLOCK)[:, None, None] - ATTN_BLOCK + kj[None]
    valid = (dist >= 0)[None] & (dist < WINDOW)[None] & (key_pos >= 0)
    scores = jnp.where(valid[None, :, None, None], scores, -jnp.inf)
    sink = sinks.astype(jnp.float32).reshape(KV_HEADS, grp)[None, None, :, :, None]
    m = jnp.maximum(scores.max(axis=-1), sink)
    e = jnp.exp(scores - m[..., None])
    probs = e / (e.sum(axis=-1) + jnp.exp(sink - m))[..., None]
    out = jnp.einsum('bnhgqk,bnkhd->bnqhgd', probs, vw)
    return out.reshape(b, s, Q_DIM)


def causal_depthwise_conv(x, w, bias):
    out = lax.conv_general_dilated(
        x, w[:, None, :], window_strides=(1,), padding=[(CONV_WIDTH - 1, 0)],
        dimension_numbers=('NWC', 'WIO', 'NWC'), feature_group_count=x.shape[-1])
    return out + bias


def ssd_chunked(xh, dt, a_neg, bm, cm):
    b, s = xh.shape[0], xh.shape[1]
    nc = s // CHUNK
    e_per = SSM_HEADS // SSM_GROUPS
    xd = (xh * dt[..., None]).reshape(b, nc, CHUNK, SSM_GROUPS, e_per, SSM_HEAD_DIM)
    a = jnp.transpose((dt * a_neg).reshape(b, nc, CHUNK, SSM_GROUPS, e_per), (0, 1, 3, 4, 2))
    a_cs = jnp.cumsum(a, axis=-1)
    bc = bm.reshape(b, nc, CHUNK, SSM_GROUPS, D_STATE)
    cc = cm.reshape(b, nc, CHUNK, SSM_GROUPS, D_STATE)
    tril = jnp.tril(jnp.ones((CHUNK, CHUNK), dtype=bool))
    diff = a_cs[..., :, None] - a_cs[..., None, :]
    decay = jnp.where(tril, jnp.exp(jnp.where(tril, diff, 0.0)), 0.0)
    cb = jnp.einsum('bclgn,bcsgn->bcgls', cc, bc)
    y_diag = jnp.einsum('bcgels,bcsgep->bclgep', cb[:, :, :, None] * decay, xd)
    decay_states = jnp.exp(a_cs[..., -1:] - a_cs)
    states = jnp.einsum('bclgn,bcgel,bclgep->bcgepn', bc, decay_states, xd)
    chunk_decay = jnp.exp(a_cs[..., -1])

    def step(carry, inp):
        st, dec = inp
        return carry * dec[..., None, None] + st, carry

    init = jnp.zeros((b, SSM_GROUPS, e_per, SSM_HEAD_DIM, D_STATE), jnp.float32)
    _, prev = lax.scan(step, init, (jnp.moveaxis(states, 1, 0), jnp.moveaxis(chunk_decay, 1, 0)))
    prev = jnp.moveaxis(prev, 0, 1)
    y_off = jnp.einsum('bclgn,bcgepn,bcgel->bclgep', cc, prev, jnp.exp(a_cs))
    return (y_diag + y_off).reshape(b, s, SSM_HEADS, SSM_HEAD_DIM)


def _dense(key, shape, fan_in):
    return jax.random.normal(key, shape, jnp.float32) * (fan_in ** -0.5)


def setup_inputs(seed: int = 0) -> dict:
    key = jax.random.key(seed)
    ks = jax.random.split(key, 24)
    L = DEPTH
    ones_noise = lambda k, shape: 1.0 + 0.05 * jax.random.normal(k, shape, jnp.float32)
    dt0 = jnp.exp(jax.random.uniform(ks[5], (L, SSM_HEADS), jnp.float32, np.log(1e-3), np.log(1e-1)))
    return {
        "x": jax.random.normal(ks[0], (BATCH, SEQ, D_MODEL), jnp.float32),
        "p": jax.random.normal(ks[1], (DEPTH, BATCH, SEQ, PLE_DIM), jnp.float32),
        "positions": jnp.tile(jnp.arange(SEQ, dtype=jnp.int32)[None], (BATCH, 1)),
        "g_mix": ones_noise(ks[2], (L, D_MODEL)),
        "w_in": _dense(ks[3], (L, D_MODEL, IN_DIM), D_MODEL),
        "conv_w": _dense(ks[4], (L, CONV_WIDTH, CONV_DIM), CONV_WIDTH),
        "conv_b": 0.02 * jax.random.normal(ks[6], (L, CONV_DIM), jnp.float32),
        "dt_bias": dt0 + jnp.log(-jnp.expm1(-dt0)),
        "a_log": jnp.log(jax.random.uniform(ks[7], (L, SSM_HEADS), jnp.float32, 1.0, 16.0)),
        "d_skip": ones_noise(ks[8], (L, SSM_HEADS)),
        "g_ssd": ones_noise(ks[9], (L, D_INNER)),
        "sinks": 0.5 * jax.random.normal(ks[10], (L, ATTN_HEADS), jnp.float32),
        "w_attn_br": _dense(ks[11], (L, Q_DIM, D_MODEL), Q_DIM),
        "w_ssd_br": _dense(ks[12], (L, D_INNER, D_MODEL), D_INNER),
        "w_o": _dense(ks[13], (L, D_MODEL, D_MODEL), D_MODEL),
        "g_ffn": ones_noise(ks[14], (L, D_MODEL)),
        "w_gate": _dense(ks[15], (L, D_MODEL, FFN_HIDDEN), D_MODEL),
        "w_up": _dense(ks[16], (L, D_MODEL, FFN_HIDDEN), D_MODEL),
        "w_down": _dense(ks[17], (L, FFN_HIDDEN, D_MODEL), FFN_HIDDEN),
        "g_ple": ones_noise(ks[18], (L, D_MODEL)),
        "w_ple_gate": _dense(ks[19], (L, D_MODEL, D_MODEL), D_MODEL),
        "w_ple_proj": _dense(ks[20], (L, PLE_DIM, D_MODEL), PLE_DIM),
        "g_final": ones_noise(ks[21], (D_MODEL,)),
    }


def reference(x, p, positions, g_mix, w_in, conv_w, conv_b, dt_bias, a_log, d_skip, g_ssd,
              sinks, w_attn_br, w_ssd_br, w_o, g_ffn, w_gate, w_up, w_down, g_ple,
              w_ple_gate, w_ple_proj, g_final):
    b, s = x.shape[0], x.shape[1]
    f32 = jnp.float32
    sizes = [Q_DIM, KV_DIM, KV_DIM, D_INNER, CONV_DIM, SSM_HEADS, D_MODEL, D_MODEL]
    offsets = [int(o) for o in np.cumsum(sizes)[:-1]]
    h = x
    for i in range(DEPTH):
        u = rmsnorm(h, g_mix[i])
        proj = u @ w_in[i]
        q, k, v, z, xbc, dt_raw, g_a, g_s = jnp.split(proj, offsets, axis=-1)

        q = apply_rope(q.astype(f32).reshape(b, s, ATTN_HEADS, HEAD_DIM), positions)
        k = apply_rope(k.astype(f32).reshape(b, s, KV_HEADS, HEAD_DIM), positions)
        v = v.astype(f32).reshape(b, s, KV_HEADS, HEAD_DIM)
        attn = sliding_window_sink_attention(q, k, v, sinks[i]).astype(x.dtype)
        out_a = attn @ w_attn_br[i]

        xbc = jax.nn.silu(causal_depthwise_conv(xbc, conv_w[i], conv_b[i])).astype(f32)
        xs, bm, cm = jnp.split(xbc, [D_INNER, D_INNER + SSM_GROUPS * D_STATE], axis=-1)
        xh = xs.reshape(b, s, SSM_HEADS, SSM_HEAD_DIM)
        dt = jax.nn.softplus(dt_raw.astype(f32) + dt_bias[i].astype(f32))
        a_neg = -jnp.exp(a_log[i].astype(f32))
        y = ssd_chunked(xh, dt, a_neg,
                        bm.reshape(b, s, SSM_GROUPS, D_STATE),
                        cm.reshape(b, s, SSM_GROUPS, D_STATE))
        y = (y + d_skip[i].astype(f32)[:, None] * xh).reshape(b, s, D_INNER)
        y = rmsnorm(y * jax.nn.silu(z.astype(f32)), g_ssd[i], SSM_NORM_EPS).astype(x.dtype)
        out_s = y @ w_ssd_br[i]

        merged = jax.nn.sigmoid(g_a) * out_a + jax.nn.sigmoid(g_s) * out_s
        h = h + merged @ w_o[i]

        f = rmsnorm(h, g_ffn[i])
        h = h + (jax.nn.silu(f @ w_gate[i]) * (f @ w_up[i])) @ w_down[i]

        gate = jax.nn.sigmoid(rmsnorm(h, g_ple[i]) @ w_ple_gate[i])
        h = h + gate * (p[i] @ w_ple_proj[i])
    return rmsnorm(h, g_final)
```

```cpp
#include <hip/hip_runtime.h>
#include <hip/hip_cooperative_groups.h>
#include <cstdio>
#include <cstdint>
namespace cg = cooperative_groups;
namespace pg8 {
#define PG8_LAS __attribute__((address_space(3)))
typedef unsigned short bf16_t;
typedef short bf16x8 __attribute__((ext_vector_type(8)));
typedef float f32x4 __attribute__((ext_vector_type(4)));
typedef unsigned u32x4 __attribute__((ext_vector_type(4)));
constexpr int BM = 256, BK = 64, HALF = 128, HTB = HALF * BK * 2  , STAGE_BYTES = 8 * HTB, NXCD = 8, WGM = 8;

__host__ __device__ __forceinline__ int lds_byte(int r, int c) { const int st = (r >> 4) * 2 + (c >> 5), rr = r & 15, cc = c & 31, ob = rr * 64 + cc * 2; return st * 1024 + (ob ^ (((ob >> 9) & 1) << 5)); }
__host__ __device__ __forceinline__ void stage_rc(int b, int& R, int& C) { const int st = b / 1024, sb = b % 1024, swz = sb ^ (((sb >> 9) & 1) << 5); R = (st >> 1) * 16 + swz / 64; C = (st & 1) * 32 + (swz % 64) / 2; }
__host__ __device__ __forceinline__ int perm32(int rho) { const int n = rho >> 4, i = rho & 15; return 8 * (i >> 2) + 4 * n + (i & 3); }

struct Unit { int pm, pn; };
struct Gemm { const bf16_t* A; const bf16_t* Bt; int M, N, K; };

struct StaticOrder {
    int nM, nN, nwg, G, c;
    __host__ __device__ void init(int M, int N, int G_, int c_) { nM = M / BM; nN = N / BM; nwg = nM * nN; G = G_; c = c_; }
    __host__ __device__ bool next(int i, Unit& u) const {
        const long L = (long)i * G + c; if (L >= nwg) return false;
        int wgid = (int)L; { const int q = nwg / NXCD, r = nwg % NXCD, xcd = wgid % NXCD, off = wgid / NXCD; wgid = (xcd < r ? xcd * (q + 1) : r * (q + 1) + (xcd - r) * q) + off; }
        const int nig = WGM * nN, gid = wgid / nig, fm = gid * WGM, gsz = (nM - fm) < WGM ? (nM - fm) : WGM;
        u.pm = fm + ((wgid % nig) % gsz); u.pn = (wgid % nig) / gsz; return true;
    }
    __device__ __forceinline__ void a_ready(const Unit&) const {}
    __device__ __forceinline__ void done(const Unit&) const {}
};


typedef unsigned u32x2 __attribute__((ext_vector_type(2)));
typedef float f32x2v __attribute__((ext_vector_type(2)));
typedef __bf16 bf16x2v __attribute__((ext_vector_type(2)));
__device__ __forceinline__ unsigned pk_bf16(float lo, float hi) { f32x2v v = {lo, hi}; bf16x2v b = __builtin_convertvector(v, bf16x2v); return __builtin_bit_cast(unsigned, b); }
__device__ __forceinline__ float bf_lo(unsigned u) { return __uint_as_float(u << 16); }
__device__ __forceinline__ float bf_hi(unsigned u) { return __uint_as_float(u & 0xffff0000u); }
__device__ __forceinline__ float sigmoid_f(float x) { return __builtin_amdgcn_rcpf(1.f + __expf(-x)); }
__device__ __forceinline__ float silu_f(float x) { return x * sigmoid_f(x); }
__device__ __forceinline__ float softplus_f(float x) { return x > 20.f ? x : log1pf(expf(x)); }
constexpr float QSCALE = 0.125f * 1.4426950408889634f;


struct EpiProj {
    static constexpr bool PERM = true, AFTER_DRAIN = false;
    bf16_t *q, *k, *v, *sz, *xbc, *ga, *gs; float* dt; const float* cs; const float* dt_bias;
    template <int MODE> __device__ __forceinline__ void plain(const f32x4 (&acc)[2][2][4][2], bf16_t* dst, int ld, int row0, int cw) const {
#pragma unroll
        for (int ai = 0; ai < 2; ++ai)
#pragma unroll
            for (int m = 0; m < 4; ++m) { bf16_t* rowp = dst + (size_t)(row0 + ai * HALF + m * 16) * ld + cw;
#pragma unroll
                for (int bj = 0; bj < 2; ++bj) { f32x4 v0 = acc[ai][bj][m][0], v1 = acc[ai][bj][m][1];
                    if (MODE == 1) { for (int e = 0; e < 4; ++e) { v0[e] = silu_f(v0[e]); v1[e] = silu_f(v1[e]); } }
                    if (MODE == 2) { for (int e = 0; e < 4; ++e) { v0[e] = sigmoid_f(v0[e]); v1[e] = sigmoid_f(v1[e]); } }
                    u32x4 w; w.x = pk_bf16(v0[0], v0[1]); w.y = pk_bf16(v0[2], v0[3]); w.z = pk_bf16(v1[0], v1[1]); w.w = pk_bf16(v1[2], v1[3]);
                    *(u32x4*)(rowp + bj * HALF) = w; } }
    }
    __device__ __forceinline__ void operator()(const f32x4 (&acc)[2][2][4][2], const Unit& u, int wr, int wc, int fr, int fq) const {
        const int pn = u.pn, row0 = u.pm * BM + wr * 64 + fr, cw = wc * 32 + 8 * fq;
        if (pn < 5) {
            bf16_t* dst = pn < 4 ? q + pn * 256 : k; const int ld = pn < 4 ? 1024 : 256; const float sc = pn < 4 ? QSCALE : 1.f;
            const int i0 = (wc & 1) * 16 + 4 * fq;
#pragma unroll
            for (int ai = 0; ai < 2; ++ai)
#pragma unroll
                for (int m = 0; m < 4; ++m) { const int row = row0 + ai * HALF + m * 16;
                    const f32x4* t = (const f32x4*)(cs + ((size_t)row * 32 + i0) * 2); const f32x4 t0 = t[0], t1 = t[1];
#pragma unroll
                    for (int bj = 0; bj < 2; ++bj) { const f32x4 v0 = acc[ai][bj][m][0], v1 = acc[ai][bj][m][1];
                        const float o0 = (v0[0] * t0[0] - v0[1] * t0[1]) * sc, o1 = (v0[1] * t0[0] + v0[0] * t0[1]) * sc;
                        const float o2 = (v0[2] * t0[2] - v0[3] * t0[3]) * sc, o3 = (v0[3] * t0[2] + v0[2] * t0[3]) * sc;
                        const float o4 = (v1[0] * t1[0] - v1[1] * t1[1]) * sc, o5 = (v1[1] * t1[0] + v1[0] * t1[1]) * sc;
                        const float o6 = (v1[2] * t1[2] - v1[3] * t1[3]) * sc, o7 = (v1[3] * t1[2] + v1[2] * t1[3]) * sc;
                        u32x4 w; w.x = pk_bf16(o0, o1); w.y = pk_bf16(o2, o3); w.z = pk_bf16(o4, o5); w.w = pk_bf16(o6, o7);
                        *(u32x4*)(dst + (size_t)row * ld + bj * HALF + cw) = w; } }
        } else if (pn == 5) plain<0>(acc, v, 256, row0, cw);
        else if (pn < 14) plain<1>(acc, sz + (pn - 6) * 256, 2048, row0, cw);
        else if (pn < 26) plain<0>(acc, xbc + (pn - 14) * 256, 3072, row0, cw);
        else if (pn < 34) plain<2>(acc, ga + (pn - 26) * 256, 2048, row0, cw);
        else if (pn < 42) plain<2>(acc, gs + (pn - 34) * 256, 2048, row0, cw);
        else if (wc == 0) {
            const f32x4 b0 = *(const f32x4*)(dt_bias + 8 * fq), b1 = *(const f32x4*)(dt_bias + 8 * fq + 4);
#pragma unroll
            for (int ai = 0; ai < 2; ++ai)
#pragma unroll
                for (int m = 0; m < 4; ++m) { float* rowp = dt + (size_t)(row0 + ai * HALF + m * 16) * 32 + 8 * fq;
                    f32x4 v0 = acc[ai][0][m][0] + b0, v1 = acc[ai][0][m][1] + b1;
                    for (int e = 0; e < 4; ++e) { v0[e] = softplus_f(v0[e]); v1[e] = softplus_f(v1[e]); }
                    *(f32x4*)rowp = v0; *(f32x4*)(rowp + 4) = v1; }
        }
    }
};

struct EpiGateA {
    static constexpr bool PERM = true, AFTER_DRAIN = false;
    const bf16_t* ga; float* tmp;
    __device__ __forceinline__ void operator()(const f32x4 (&acc)[2][2][4][2], const Unit& u, int wr, int wc, int fr, int fq) const {
        const int row0 = u.pm * BM + wr * 64 + fr, col0 = u.pn * BM + wc * 32 + 8 * fq;
#pragma unroll
        for (int ai = 0; ai < 2; ++ai)
#pragma unroll
            for (int m = 0; m < 4; ++m) { const size_t off = (size_t)(row0 + ai * HALF + m * 16) * 2048 + col0;
#pragma unroll
                for (int bj = 0; bj < 2; ++bj) { const u32x4 g = *(const u32x4*)(ga + off + bj * HALF);
                    f32x4 v0 = acc[ai][bj][m][0], v1 = acc[ai][bj][m][1];
                    v0[0] *= bf_lo(g.x); v0[1] *= bf_hi(g.x); v0[2] *= bf_lo(g.y); v0[3] *= bf_hi(g.y); v1[0] *= bf_lo(g.z); v1[1] *= bf_hi(g.z); v1[2] *= bf_lo(g.w); v1[3] *= bf_hi(g.w);
                    *(f32x4*)(tmp + off + bj * HALF) = v0; *(f32x4*)(tmp + off + bj * HALF + 4) = v1; } }
    }
};
struct EpiGateS {
    static constexpr bool PERM = true, AFTER_DRAIN = false;
    const bf16_t* gs; const float* tmp; const float* ssq; bf16_t* merged;
    __device__ __forceinline__ void operator()(const f32x4 (&acc)[2][2][4][2], const Unit& u, int wr, int wc, int fr, int fq) const {
        const int row0 = u.pm * BM + wr * 64 + fr, col0 = u.pn * BM + wc * 32 + 8 * fq;
#pragma unroll
        for (int ai = 0; ai < 2; ++ai)
#pragma unroll
            for (int m = 0; m < 4; ++m) { const int row = row0 + ai * HALF + m * 16; const size_t off = (size_t)row * 2048 + col0;
                const f32x4 s4 = *(const f32x4*)(ssq + (size_t)row * 8), s5 = *(const f32x4*)(ssq + (size_t)row * 8 + 4);
                const float r = rsqrtf((((s4[0] + s4[1]) + (s4[2] + s4[3])) + ((s5[0] + s5[1]) + (s5[2] + s5[3]))) * (1.f / 2048.f) + 1e-5f);
#pragma unroll
                for (int bj = 0; bj < 2; ++bj) { const u32x4 g = *(const u32x4*)(gs + off + bj * HALF);
                    const f32x4 t0 = *(const f32x4*)(tmp + off + bj * HALF), t1 = *(const f32x4*)(tmp + off + bj * HALF + 4);
                    f32x4 v0 = acc[ai][bj][m][0] * r, v1 = acc[ai][bj][m][1] * r;
                    v0[0] = t0[0] + v0[0] * bf_lo(g.x); v0[1] = t0[1] + v0[1] * bf_hi(g.x); v0[2] = t0[2] + v0[2] * bf_lo(g.y); v0[3] = t0[3] + v0[3] * bf_hi(g.y);
                    v1[0] = t1[0] + v1[0] * bf_lo(g.z); v1[1] = t1[1] + v1[1] * bf_hi(g.z); v1[2] = t1[2] + v1[2] * bf_lo(g.w); v1[3] = t1[3] + v1[3] * bf_hi(g.w);
                    u32x4 w; w.x = pk_bf16(v0[0], v0[1]); w.y = pk_bf16(v0[2], v0[3]); w.z = pk_bf16(v1[0], v1[1]); w.w = pk_bf16(v1[2], v1[3]);
                    *(u32x4*)(merged + off + bj * HALF) = w; } }
    }
};
template <int MODE> struct EpiRes {
    static constexpr bool PERM = false, AFTER_DRAIN = false;
    const float* res; float* out; bf16_t* hb; float* ss; const float* ssin; const float* tmp; PG8_LAS float* xlds; float eps;
    __device__ __forceinline__ void operator()(const f32x4 (&acc)[2][2][4][2], const Unit& u, int wr, int wc, int fr, int fq) const {
        const int row0 = u.pm * BM + wr * 64 + fr, col0 = u.pn * BM + wc * 32 + 4 * fq;
#pragma unroll
        for (int ai = 0; ai < 2; ++ai)
#pragma unroll
            for (int m = 0; m < 4; ++m) { const int row = row0 + ai * HALF + m * 16; const size_t off = (size_t)row * 2048 + col0; float s = 0.f, r = 1.f;
                if (MODE == 1) { const f32x4 a = *(const f32x4*)(ssin + (size_t)row * 8), b = *(const f32x4*)(ssin + (size_t)row * 8 + 4);
                    r = rsqrtf((((a[0] + a[1]) + (a[2] + a[3])) + ((b[0] + b[1]) + (b[2] + b[3]))) * (1.f / 2048.f) + eps); }
#pragma unroll
                for (int bj = 0; bj < 2; ++bj)
#pragma unroll
                    for (int n = 0; n < 2; ++n) { const size_t o = off + bj * HALF + n * 16; f32x4 h = *(const f32x4*)(res + o); f32x4 a = acc[ai][bj][m][n];
                        if (MODE == 1) { const f32x4 t = *(const f32x4*)(tmp + o); for (int e = 0; e < 4; ++e) a[e] = sigmoid_f(a[e] * r) * t[e]; }
                        h = h + a; *(f32x4*)(out + o) = h;
                        if (hb) { u32x2 w; w.x = pk_bf16(h[0], h[1]); w.y = pk_bf16(h[2], h[3]); *(u32x2*)(hb + o) = w; }
                        s += (h[0] * h[0] + h[1] * h[1]) + (h[2] * h[2] + h[3] * h[3]);
                        if (MODE == 1) asm volatile("" ::: "memory"); }
                s += __shfl_xor(s, 16); s += __shfl_xor(s, 32);
                if (fq == 0) xlds[(ai * HALF + wr * 64 + m * 16 + fr) * 4 + wc] = s;
                if (MODE == 1) asm volatile("" ::: "memory"); }
        asm volatile("s_waitcnt lgkmcnt(0)" ::: "memory"); __builtin_amdgcn_s_barrier(); asm volatile("" ::: "memory");
        const int t = threadIdx.x;
        if (t < 256) { const f32x4 x = *(const PG8_LAS f32x4*)(xlds + t * 4); ss[(size_t)(u.pm * BM + t) * 8 + u.pn] = (x[0] + x[1]) + (x[2] + x[3]); }
    }
};
struct EpiGU {
    static constexpr bool PERM = true, AFTER_DRAIN = false;
    const float* ssin; bf16_t* act; float eps;
    __device__ __forceinline__ void operator()(const f32x4 (&acc)[2][2][4][2], const Unit& u, int wr, int wc, int fr, int fq) const {
        const int row0 = u.pm * BM + wr * 64 + fr, col0 = u.pn * HALF + wc * 32 + 8 * fq;
#pragma unroll
        for (int ai = 0; ai < 2; ++ai)
#pragma unroll
            for (int m = 0; m < 4; ++m) { const int row = row0 + ai * HALF + m * 16;
                const f32x4 a = *(const f32x4*)(ssin + (size_t)row * 8), b = *(const f32x4*)(ssin + (size_t)row * 8 + 4);
                const float r = rsqrtf((((a[0] + a[1]) + (a[2] + a[3])) + ((b[0] + b[1]) + (b[2] + b[3]))) * (1.f / 2048.f) + eps);
                const f32x4 g0 = acc[ai][0][m][0] * r, g1 = acc[ai][0][m][1] * r, u0 = acc[ai][1][m][0] * r, u1 = acc[ai][1][m][1] * r;
                u32x4 w; w.x = pk_bf16(silu_f(g0[0]) * u0[0], silu_f(g0[1]) * u0[1]); w.y = pk_bf16(silu_f(g0[2]) * u0[2], silu_f(g0[3]) * u0[3]);
                w.z = pk_bf16(silu_f(g1[0]) * u1[0], silu_f(g1[1]) * u1[1]); w.w = pk_bf16(silu_f(g1[2]) * u1[2], silu_f(g1[3]) * u1[3]);
                *(u32x4*)(act + (size_t)row * 5632 + col0) = w; }
    }
};
struct EpiF32 {
    static constexpr bool PERM = false, AFTER_DRAIN = false;
    float* C;
    __device__ __forceinline__ void operator()(const f32x4 (&acc)[2][2][4][2], const Unit& u, int wr, int wc, int fr, int fq) const {
        const int row0 = u.pm * BM + wr * 64 + fr, col0 = u.pn * BM + wc * 32 + 4 * fq;
#pragma unroll
        for (int ai = 0; ai < 2; ++ai)
#pragma unroll
            for (int m = 0; m < 4; ++m) { float* rowp = C + (size_t)(row0 + ai * HALF + m * 16) * 2048 + col0;
#pragma unroll
                for (int bj = 0; bj < 2; ++bj)
#pragma unroll
                    for (int n = 0; n < 2; ++n) *(f32x4*)(rowp + bj * HALF + n * 16) = acc[ai][bj][m][n]; }
    }
};
template <class Epi, class Sched, bool ALIGN_EPI = false, bool SP2 = false>
__device__ __forceinline__ void gemm_phase(PG8_LAS unsigned char* lds, const Gemm g, const Sched& S, const Epi& E) {
    const int tid = threadIdx.x, wid = __builtin_amdgcn_readfirstlane(tid >> 6), lane = tid & 63, wr = wid >> 2, wc = wid & 3, fr = lane & 15, fq = lane >> 4;
    const int K = g.K, nt = K / BK;
    unsigned voffA[2], voffB[2];
#pragma unroll
    for (int i = 0; i < 2; ++i) { int R, C; stage_rc(tid * 16 + i * 8192, R, C); const int Rb = Epi::PERM ? ((R & ~31) + perm32(R & 31)) : R;
        voffA[i] = (unsigned)(R * K + C) * 2u; voffB[i] = (unsigned)(Rb * K + C) * 2u; }
    const size_t kstep = (size_t)(BK * 2);
    const size_t hstep = (size_t)HALF * K * 2;
    const size_t tstep = 2 * hstep;
    const unsigned ldsw = (unsigned)wid * 1024u;
    const int aoff = lds_byte(wr * 64 + fr, fq * 8), boff = lds_byte(wc * 32 + fr, fq * 8);
#define PG8_SA(b, h) (((b) * 2 + (h)) * HTB)
#define PG8_SB(b, h) ((4 + (b) * 2 + (h)) * HTB)
#define PG8_STAGE(bufoff, gbase, voff) do { _Pragma("unroll") for (int _i = 0; _i < 2; ++_i) \
        __builtin_amdgcn_global_load_lds((const unsigned*)((const char*)(gbase) + (voff)[_i]), (PG8_LAS unsigned*)(lds + (bufoff) + ldsw + _i * 8192), 16, 0, 0); } while (0)
#define PG8_LDA(dst, b, h) do { _Pragma("unroll") for (int m = 0; m < 4; ++m) _Pragma("unroll") for (int k = 0; k < 2; ++k) dst[m][k] = *(const PG8_LAS bf16x8*)(lds + PG8_SA(b, h) + aoff + m * 2048 + k * 1024); } while (0)
#define PG8_LDB(dst, b, h) do { _Pragma("unroll") for (int n = 0; n < 2; ++n) _Pragma("unroll") for (int k = 0; k < 2; ++k) dst[n][k] = *(const PG8_LAS bf16x8*)(lds + PG8_SB(b, h) + boff + n * 2048 + k * 1024); } while (0)
#define PG8_MMA(ai, bj, At, Bt) do { __builtin_amdgcn_s_setprio(1); _Pragma("unroll") for (int m = 0; m < 4; ++m) _Pragma("unroll") for (int n = 0; n < 2; ++n) _Pragma("unroll") for (int k = 0; k < 2; ++k) \
        acc[ai][bj][m][n] = __builtin_amdgcn_mfma_f32_16x16x32_bf16(Bt[n][k], At[m][k], acc[ai][bj][m][n], 0, 0, 0); __builtin_amdgcn_s_setprio(0); } while (0)
#define PG8_WAIT_V(n) asm volatile("s_waitcnt vmcnt(" #n ")" ::: "memory")
#define PG8_WAIT_L(n) asm volatile("s_waitcnt lgkmcnt(" #n ")" ::: "memory")
#define PG8_BAR __builtin_amdgcn_s_barrier()
#define PG8_SCHED __builtin_amdgcn_sched_barrier(0)
    Unit cur, nxt; int ui = 0;
    if (!S.next(0, cur)) return;
    f32x4 acc[2][2][4][2];
#pragma unroll
    for (int a = 0; a < 2; ++a)
#pragma unroll
        for (int b = 0; b < 2; ++b)
#pragma unroll
            for (int m = 0; m < 4; ++m)
#pragma unroll
                for (int n = 0; n < 2; ++n) acc[a][b][m][n] = (f32x4){0.f, 0.f, 0.f, 0.f};
    bf16x8 At[4][2], B0[2][2], B1[2][2];
    const char* cA = (const char*)g.A + (size_t)cur.pm * tstep; const char* cB = (const char*)g.Bt + (size_t)cur.pn * tstep;
    S.a_ready(cur);
    if constexpr (SP2) {
        PG8_STAGE(PG8_SB(0, 0), cB, voffB); PG8_STAGE(PG8_SB(0, 1), cB + hstep, voffB); PG8_STAGE(PG8_SA(0, 0), cA, voffA); PG8_STAGE(PG8_SA(0, 1), cA + hstep, voffA);
        if (wr == 1) PG8_BAR;
        PG8_WAIT_V(2); PG8_BAR;
        PG8_STAGE(PG8_SB(1, 0), cB + kstep, voffB); PG8_STAGE(PG8_SA(1, 0), cA + kstep, voffA); PG8_STAGE(PG8_SB(1, 1), cB + hstep + kstep, voffB);
        PG8_WAIT_V(6); PG8_BAR;
    } else {
        PG8_STAGE(PG8_SB(0, 0), cB, voffB); PG8_STAGE(PG8_SA(0, 0), cA, voffA); PG8_STAGE(PG8_SB(0, 1), cB + hstep, voffB); PG8_STAGE(PG8_SA(0, 1), cA + hstep, voffA);
        if (wr == 1) PG8_BAR;
        PG8_WAIT_V(4); PG8_BAR;
        PG8_STAGE(PG8_SB(1, 0), cB + kstep, voffB); PG8_STAGE(PG8_SA(1, 0), cA + kstep, voffA); PG8_STAGE(PG8_SB(1, 1), cB + hstep + kstep, voffB);
        PG8_WAIT_V(6); PG8_BAR;
    }
    for (;;) {
        const bool has_next = S.next(ui + 1, nxt);
        const char* nA = has_next ? (const char*)g.A + (size_t)nxt.pm * tstep : cA; const char* nB = has_next ? (const char*)g.Bt + (size_t)nxt.pn * tstep : cB;
        for (int t = 0; t < nt; t += 2) {
            const bool last = (t == nt - 2);
            const char* a1 = cA + (size_t)(t + 1) * kstep;
            const char* a2 = last ? nA : cA + (size_t)(t + 2) * kstep; const char* b2 = last ? nB : cB + (size_t)(t + 2) * kstep;
            const char* a3 = a2 + kstep; const char* b3 = b2 + kstep;
            if (last && has_next) S.a_ready(nxt);
            if constexpr (SP2) {
            PG8_LDB(B0, 0, 0); PG8_LDB(B1, 0, 1); PG8_SCHED; PG8_LDA(At, 0, 0); PG8_STAGE(PG8_SA(1, 1), a1 + hstep, voffA);
            PG8_WAIT_V(8); PG8_WAIT_L(0); PG8_BAR; PG8_MMA(0, 0, At, B0); PG8_MMA(0, 1, At, B1); PG8_BAR; PG8_SCHED;
            PG8_LDA(At, 0, 1); PG8_STAGE(PG8_SB(0, 0), b2, voffB); PG8_STAGE(PG8_SB(0, 1), b2 + hstep, voffB); PG8_STAGE(PG8_SA(0, 0), a2, voffA);
            PG8_WAIT_V(8); PG8_WAIT_L(0); PG8_BAR; PG8_MMA(1, 0, At, B0); PG8_MMA(1, 1, At, B1); PG8_BAR; PG8_SCHED;
            PG8_LDB(B0, 1, 0); PG8_LDB(B1, 1, 1); PG8_SCHED; PG8_LDA(At, 1, 0); PG8_STAGE(PG8_SA(0, 1), a2 + hstep, voffA);
            PG8_WAIT_V(8); PG8_WAIT_L(0); PG8_BAR; PG8_MMA(0, 0, At, B0); PG8_MMA(0, 1, At, B1); PG8_BAR; PG8_SCHED;
            PG8_LDA(At, 1, 1); PG8_STAGE(PG8_SB(1, 0), b3, voffB); PG8_STAGE(PG8_SB(1, 1), b3 + hstep, voffB); PG8_STAGE(PG8_SA(1, 0), a3, voffA);
            PG8_WAIT_V(8); PG8_WAIT_L(0); PG8_BAR; PG8_MMA(1, 0, At, B0); PG8_MMA(1, 1, At, B1); PG8_BAR; PG8_SCHED;
            } else {
            PG8_LDB(B0, 0, 0); PG8_SCHED; PG8_LDA(At, 0, 0); PG8_STAGE(PG8_SA(1, 1), a1 + hstep, voffA);
            PG8_WAIT_L(8); PG8_BAR; PG8_WAIT_L(0); PG8_MMA(0, 0, At, B0); PG8_BAR; PG8_SCHED;
            PG8_LDB(B1, 0, 1); PG8_STAGE(PG8_SB(0, 0), b2, voffB);
            PG8_BAR; PG8_WAIT_L(0); PG8_MMA(0, 1, At, B1); PG8_BAR;
            PG8_LDA(At, 0, 1); PG8_STAGE(PG8_SA(0, 0), a2, voffA);
            PG8_BAR; PG8_WAIT_L(0); PG8_MMA(1, 0, At, B0); PG8_BAR; PG8_SCHED;
            PG8_STAGE(PG8_SB(0, 1), b2 + hstep, voffB);
            PG8_WAIT_V(6); PG8_BAR; PG8_MMA(1, 1, At, B1); PG8_BAR;
            PG8_LDB(B0, 1, 0); PG8_SCHED; PG8_LDA(At, 1, 0); PG8_STAGE(PG8_SA(0, 1), a2 + hstep, voffA);
            PG8_WAIT_L(8); PG8_BAR; PG8_WAIT_L(0); PG8_MMA(0, 0, At, B0); PG8_BAR; PG8_SCHED;
            PG8_LDB(B1, 1, 1); PG8_STAGE(PG8_SB(1, 0), b3, voffB);
            PG8_BAR; PG8_WAIT_L(0); PG8_MMA(0, 1, At, B1); PG8_BAR;
            PG8_LDA(At, 1, 1); PG8_STAGE(PG8_SA(1, 0), a3, voffA);
            PG8_BAR; PG8_WAIT_L(0); PG8_MMA(1, 0, At, B0); PG8_BAR; PG8_SCHED;
            PG8_STAGE(PG8_SB(1, 1), b3 + hstep, voffB);
            PG8_WAIT_V(6); PG8_BAR; PG8_MMA(1, 1, At, B1); PG8_BAR;
            }
        }
        if constexpr (ALIGN_EPI) { if (wr == 0) PG8_BAR; }
        if constexpr (!Epi::AFTER_DRAIN) { E(acc, cur, wr, wc, fr, fq); S.done(cur); }
        if (!has_next) break;
#pragma unroll
        for (int a = 0; a < 2; ++a)
#pragma unroll
            for (int b = 0; b < 2; ++b)
#pragma unroll
                for (int m = 0; m < 4; ++m)
#pragma unroll
                    for (int n = 0; n < 2; ++n) acc[a][b][m][n] = (f32x4){0.f, 0.f, 0.f, 0.f};
        cur = nxt; cA = nA; cB = nB; ++ui;
        if constexpr (ALIGN_EPI) { if (wr == 1) PG8_BAR; }
    }
    PG8_WAIT_V(0);
    if constexpr (!ALIGN_EPI) { if (wr == 0) PG8_BAR; }
    PG8_BAR;
    if constexpr (Epi::AFTER_DRAIN) { E.fused(acc, cur, wr, wc, fr, fq, lds, wid, lane); S.done(cur); }
#undef PG8_SA
#undef PG8_SB
#undef PG8_STAGE
#undef PG8_LDA
#undef PG8_LDB
#undef PG8_MMA
#undef PG8_WAIT_V
#undef PG8_WAIT_L
#undef PG8_BAR
#undef PG8_SCHED
}
}

#ifndef MK_N_LAUNCHES
#define MK_N_LAUNCHES 11
#endif
constexpr int NPHASE = 11;
constexpr int NWAVES = 8, NTHREADS = 512;
constexpr int BATCH = 4, SEQ = 2048, DM = 2048, M = BATCH * SEQ;
constexpr int QD = 1024, KVD = 256, DI = 2048, CONVD = 3072, NH = 32, FF = 5632, PLE = 256;
constexpr int NIN = 10784, NINP = 11008;
constexpr int NCH = SEQ / 128;
constexpr size_t MiB = 1u << 20;
constexpr size_t WS_CTL = 0, CTL_ZERO_BYTES = 65536;
constexpr size_t WS_CS = 1 * MiB;
constexpr size_t WS_SSQ = 3 * MiB, WS_SS1 = WS_SSQ + 256 * 1024, WS_SS2 = WS_SS1 + 256 * 1024, WS_SS3 = WS_SS2 + 256 * 1024;
constexpr size_t WS_ACS = 4 * MiB, WS_DT = 5 * MiB;
constexpr size_t WS_WIN = 6 * MiB, WS_U = 49 * MiB;
constexpr size_t WS_WATTN = 81 * MiB, WS_WSSD = 85 * MiB, WS_WO = 93 * MiB, WS_WGU = 101 * MiB, WS_WDOWN = 145 * MiB, WS_WPG = 167 * MiB, WS_WPP = 175 * MiB;
constexpr size_t WS_Q = 176 * MiB, WS_K = 192 * MiB, WS_V = 196 * MiB, WS_SZ = 200 * MiB, WS_XBC = 232 * MiB;
constexpr size_t WS_ATTN = 280 * MiB, WS_PREV = 296 * MiB, WS_PB = 328 * MiB, WS_END = 332 * MiB;
constexpr size_t WS_STATES = 6 * MiB;
constexpr size_t WS_YP = 6 * MiB;
constexpr size_t WS_TMP = 176 * MiB, WS_MERGED = 240 * MiB;
constexpr size_t WS_H1B = 6 * MiB, WS_ACT = 176 * MiB, WS_H2B = 38 * MiB;
static_assert(WS_WIN + (size_t)NINP * DM * 2 <= WS_U && WS_U + (size_t)M * DM * 2 <= WS_WATTN && WS_WPP + (size_t)DM * PLE * 2 <= WS_Q, "ws map 1");
static_assert(WS_XBC + (size_t)M * CONVD * 2 <= WS_ATTN && WS_PB + (size_t)M * PLE * 2 <= WS_END && WS_STATES + (size_t)M / 128 * NH * 8192 * 4 <= WS_WATTN, "ws map 2");
static_assert(WS_ACT + (size_t)M * FF * 2 <= WS_ATTN && WS_MERGED + (size_t)M * DM * 2 <= WS_ATTN && WS_WGU + (size_t)2 * FF * DM * 2 <= WS_WDOWN && WS_WDOWN + (size_t)DM * FF * 2 <= WS_WPG, "ws map 3");
constexpr int CW_BAR = 4096;
constexpr int RING_BYTES = 131072, XLDS_OFF = RING_BYTES, LDS_BYTES = 147456, MISC_OFF = LDS_BYTES - 256;

#define GAS __attribute__((address_space(1)))
#define LAS __attribute__((address_space(3)))
typedef unsigned short bf16;
typedef unsigned v4u __attribute__((ext_vector_type(4)));
typedef unsigned v2u __attribute__((ext_vector_type(2)));
typedef float f32x4 __attribute__((ext_vector_type(4)));
typedef float f32x16 __attribute__((ext_vector_type(16)));
typedef float f32x2p __attribute__((ext_vector_type(2)));
typedef short bf16x8 __attribute__((ext_vector_type(8)));
#define LDS_WAIT() asm volatile("s_waitcnt lgkmcnt(0)" ::: "memory")
#define VM_WAIT() asm volatile("s_waitcnt vmcnt(0)" ::: "memory")
using pg8::pk_bf16; using pg8::bf_lo; using pg8::bf_hi; using pg8::silu_f; using pg8::sigmoid_f;
__device__ __forceinline__ float bf2f(bf16 x) { return __uint_as_float((unsigned)x << 16); }
constexpr float LOG2E = 1.4426950408889634f;

#define XB_TMO      128
#define XB_XCNT(j)  (256  + 64 * (j))
#define XB_XSUB(j)  (1280 + 64 * (j))
#define XB_XGEN(j)  (2304 + 64 * (j))
#define XB_TOP      3328
#define XB_TOPGEN   3392
#define XCD_BAR_WORDS 3456
#define XB_SPIN_CAP (1u << 18)
__device__ __forceinline__ unsigned xb_ld(unsigned* p)              { return __hip_atomic_load(p, __ATOMIC_RELAXED, __HIP_MEMORY_SCOPE_AGENT); }
__device__ __forceinline__ unsigned xb_add(unsigned* p, unsigned v) { return __hip_atomic_fetch_add(p, v, __ATOMIC_RELAXED, __HIP_MEMORY_SCOPE_AGENT); }
__device__ __forceinline__ unsigned xb_xcc_id() { return (unsigned)__builtin_amdgcn_s_getreg((3 << 11) | 20) & 0xFu; }
#define XB_SPIN(cond, bar) do { unsigned _sp = 0; while (cond) { __builtin_amdgcn_s_sleep(1); \
    if ((++_sp & 255u) == 0u) { if (xb_ld(&(bar)[XB_TMO])) break; if (_sp > XB_SPIN_CAP) { atomicAdd(&(bar)[XB_TMO], 1u); break; } } } } while (0)
struct XcdBarrier { unsigned* bar; unsigned x; volatile LAS unsigned* st; };
__device__ __forceinline__ XcdBarrier xcd_barrier_post(unsigned* bar, volatile LAS unsigned* st) {
    XcdBarrier b; b.bar = bar; b.x = xb_xcc_id(); b.st = st;
    if (threadIdx.x == 0) (void)xb_add(&bar[XB_XCNT(b.x)], 1u);
    return b;
}
__device__ __forceinline__ void xcd_barrier_complete(unsigned* bar, unsigned x, unsigned& nloc, unsigned& nx) {
    const unsigned G = gridDim.x * gridDim.y * gridDim.z;
    unsigned sum, cnt, mine, sp = 0u;
    for (;;) {
        sum = 0u; cnt = 0u; mine = 0u;
#pragma unroll
        for (unsigned j = 0; j < 16; ++j) { const unsigned c = xb_ld(&bar[XB_XCNT(j)]); sum += c; cnt += (c > 0u) ? 1u : 0u; mine = (j == x) ? c : mine; }
        if (sum == G) break;
        __builtin_amdgcn_s_sleep(1);
        if ((++sp & 255u) == 0u) { if (xb_ld(&bar[XB_TMO])) break; if (sp > XB_SPIN_CAP) { atomicAdd(&bar[XB_TMO], 1u); break; } }
    }
    nloc = mine > 0u ? mine : 1u; nx = cnt > 0u ? cnt : 1u;
}
__device__ __forceinline__ void xcd_barrier(const XcdBarrier& b) {
    asm volatile("s_waitcnt vmcnt(0)" ::: "memory");
    __syncthreads();
    if (threadIdx.x == 0) {
        unsigned* bar = b.bar;
        __builtin_amdgcn_s_waitcnt(0);
        unsigned nloc = b.st[0], nx = b.st[1];
        if (nloc == 0u) { xcd_barrier_complete(bar, b.x, nloc, nx); b.st[0] = nloc; b.st[1] = nx; }
        const unsigned old = xb_add(&bar[XB_XSUB(b.x)], 1u);
        const unsigned gen = old / nloc;
        if (old + 1u == (gen + 1u) * nloc) {
            __builtin_amdgcn_fence(__ATOMIC_RELEASE, "agent");
            asm volatile("s_waitcnt vmcnt(0)" ::: "memory");
            const unsigned og = xb_add(&bar[XB_TOP], 1u);
            const unsigned tg = og / nx;
            if (og + 1u == (tg + 1u) * nx) xb_add(&bar[XB_TOPGEN], 1u);
            else XB_SPIN(xb_ld(&bar[XB_TOPGEN]) == tg, bar);
            __builtin_amdgcn_fence(__ATOMIC_ACQUIRE, "agent");
            xb_add(&bar[XB_XGEN(b.x)], 1u);
            asm volatile("s_waitcnt vmcnt(0)" ::: "memory");
        } else {
            XB_SPIN(xb_ld(&bar[XB_XGEN(b.x)]) == gen, bar);
            __builtin_amdgcn_fence(__ATOMIC_ACQUIRE, "agent");
            asm volatile("s_waitcnt vmcnt(0)" ::: "memory");
        }
    }
    __syncthreads();
}

enum { I_X = 0, I_P, I_POS, I_GMIX, I_WIN, I_CONVW, I_CONVB, I_DTB, I_ALOG, I_DSKIP, I_GSSD, I_SINKS, I_WATTN, I_WSSD, I_WO, I_GFFN, I_WGATE, I_WUP, I_WDOWN, I_GPLE, I_WPG, I_WPP, I_GFIN, N_IN };
struct Args { const void* in[N_IN]; float* out; unsigned char* ws; int ph_lo, ph_hi; };

__device__ __forceinline__ float wave_sum(float v) {
#pragma unroll
    for (int o = 1; o < 64; o <<= 1) v += __shfl_xor(v, o);
    return v;
}

__device__ __forceinline__ int phys_row(int kind, int n) {
    if (kind == 0) return n;
    if (kind == 1) {
        if (n < 1280) { const int d = n & 63; return (n & ~63) + 2 * (d & 31) + (d >> 5); }
        if (n < 6656) return n;
        if (n < 6688) return 10752 + (n - 6656);
        return n - 32;
    }
    if (kind == 2) return ((n >> 7) << 8) + (n & 127);
    return ((n >> 7) << 8) + 128 + (n & 127);
}
__device__ __forceinline__ void p0_item(const float* W, int K, int N, bf16* WT, const float* g, int kind, LAS float* scr, int item, int lane) {
    const int nblk = N / 32, kb = item / nblk, nb = item % nblk, k0 = 64 * kb, n0 = 32 * nb;
#pragma unroll 8
    for (int i = 0; i < 32; ++i) { const int kk = 2 * i + (lane >> 5); float v = W[(size_t)(k0 + kk) * N + n0 + (lane & 31)]; if (g) v *= g[k0 + kk]; scr[kk * 33 + (lane & 31)] = v; }
    LDS_WAIT(); asm volatile("" ::: "memory");
    const int c = lane & 7;
#pragma unroll
    for (int j = 0; j < 4; ++j) { const int n = (lane >> 3) + 8 * j; const LAS float* s = scr + (8 * c) * 33 + n;
        v4u o; o.x = pk_bf16(s[0 * 33], s[1 * 33]); o.y = pk_bf16(s[2 * 33], s[3 * 33]); o.z = pk_bf16(s[4 * 33], s[5 * 33]); o.w = pk_bf16(s[6 * 33], s[7 * 33]);
        *(GAS v4u*)(WT + (size_t)phys_row(kind, n0 + n) * K + k0 + 8 * c) = o; }
    LDS_WAIT(); asm volatile("" ::: "memory");
}
__device__ __forceinline__ void p0_prologue(const Args& a, LAS unsigned char* lds, int vcu, int G) {
    const int tid = threadIdx.x, lane = tid & 63, wave = __builtin_amdgcn_readfirstlane(tid >> 6);
    unsigned char* ws = a.ws;
    LAS float* scr = (LAS float*)(lds + wave * 16384);
    const int gw = vcu * NWAVES + wave, NGW = G * NWAVES;
    constexpr int I0 = 32 * (NIN / 32), I1 = 16 * 64, I2 = 32 * 64, I3 = 32 * 64, I4 = 32 * (FF / 32), I5 = I4, I6 = (FF / 64) * 64, I7 = 32 * 64, I8 = 4 * 64;
    constexpr int NITEMS = I0 + I1 + I2 + I3 + I4 + I5 + I6 + I7 + I8;
    for (int it = gw; it < NITEMS; it += NGW) {
        int r = it;
        if (r < I0) { p0_item((const float*)a.in[I_WIN], DM, NIN, (bf16*)(ws + WS_WIN), (const float*)a.in[I_GMIX], 1, scr, r, lane); continue; } r -= I0;
        if (r < I1) { p0_item((const float*)a.in[I_WATTN], QD, DM, (bf16*)(ws + WS_WATTN), nullptr, 0, scr, r, lane); continue; } r -= I1;
        if (r < I2) { p0_item((const float*)a.in[I_WSSD], DI, DM, (bf16*)(ws + WS_WSSD), (const float*)a.in[I_GSSD], 0, scr, r, lane); continue; } r -= I2;
        if (r < I3) { p0_item((const float*)a.in[I_WO], DM, DM, (bf16*)(ws + WS_WO), nullptr, 0, scr, r, lane); continue; } r -= I3;
        if (r < I4) { p0_item((const float*)a.in[I_WGATE], DM, FF, (bf16*)(ws + WS_WGU), (const float*)a.in[I_GFFN], 2, scr, r, lane); continue; } r -= I4;
        if (r < I5) { p0_item((const float*)a.in[I_WUP], DM, FF, (bf16*)(ws + WS_WGU), (const float*)a.in[I_GFFN], 3, scr, r, lane); continue; } r -= I5;
        if (r < I6) { p0_item((const float*)a.in[I_WDOWN], FF, DM, (bf16*)(ws + WS_WDOWN), nullptr, 0, scr, r, lane); continue; } r -= I6;
        if (r < I7) { p0_item((const float*)a.in[I_WPG], DM, DM, (bf16*)(ws + WS_WPG), (const float*)a.in[I_GPLE], 0, scr, r, lane); continue; } r -= I7;
        p0_item((const float*)a.in[I_WPP], PLE, DM, (bf16*)(ws + WS_WPP), nullptr, 0, scr, r, lane);
    }
    const int gt = vcu * NTHREADS + tid, NGT = G * NTHREADS;
    { GAS v4u* z = (GAS v4u*)(ws + WS_WIN + (size_t)NIN * DM * 2); const int nz = (NINP - NIN) * DM * 2 / 16;
      for (int i = gt; i < nz; i += NGT) z[i] = (v4u){0u, 0u, 0u, 0u}; }
    { const float* x = (const float*)a.in[I_X]; bf16* U = (bf16*)(ws + WS_U);
      for (int m = gw; m < M; m += NGW) {
          const GAS f32x4* xr = (const GAS f32x4*)(x + (size_t)m * DM) + lane; f32x4 v[8]; float s = 0.f;
#pragma unroll
          for (int j = 0; j < 8; ++j) { v[j] = xr[64 * j]; s += (v[j][0] * v[j][0] + v[j][1] * v[j][1]) + (v[j][2] * v[j][2] + v[j][3] * v[j][3]); }
          const float r = rsqrtf(wave_sum(s) * (1.f / DM) + 1e-6f);
          GAS v2u* o = (GAS v2u*)(U + (size_t)m * DM) + lane;
#pragma unroll
          for (int j = 0; j < 8; ++j) { v2u w; w.x = pk_bf16(v[j][0] * r, v[j][1] * r); w.y = pk_bf16(v[j][2] * r, v[j][3] * r); o[64 * j] = w; } } }
    { const GAS f32x4* p = (const GAS f32x4*)a.in[I_P]; GAS v4u* o = (GAS v4u*)(ws + WS_PB); const int n8 = M * PLE / 8;
      for (int i = gt; i < n8; i += NGT) { const f32x4 v0 = p[2 * i], v1 = p[2 * i + 1]; v4u w; w.x = pk_bf16(v0[0], v0[1]); w.y = pk_bf16(v0[2], v0[3]); w.z = pk_bf16(v1[0], v1[1]); w.w = pk_bf16(v1[2], v1[3]); o[i] = w; } }
    { const int* pos = (const int*)a.in[I_POS]; float* cs = (float*)(ws + WS_CS);
      for (int i = gt; i < M * 32; i += NGT) { const int tok = i >> 5, fi = i & 31; const float inv = exp2f(-(float)fi * (13.287712379549449f / 32.f));
          const float ang = (float)pos[tok] * inv; float sn, cn; sincosf(ang, &sn, &cn); *(f32x2p*)(cs + 2 * (size_t)i) = (f32x2p){cn, sn}; } }
}

constexpr int KS_PITCH = 72, VT_PITCH = 264;
__device__ __forceinline__ void attn_unit(const Args& a, LAS unsigned char* lds, int unit) {
    const int tid = threadIdx.x, lane = tid & 63, wid = __builtin_amdgcn_readfirstlane(tid >> 6), r32 = lane & 31, hi = lane >> 5;
    const int hk = unit & 3, nb = (unit >> 2) & 15, b = unit >> 6;
    const bf16* Q = (const bf16*)(a.ws + WS_Q); const bf16* K = (const bf16*)(a.ws + WS_K); const bf16* V = (const bf16*)(a.ws + WS_V); bf16* O = (bf16*)(a.ws + WS_ATTN);
    const int tok0 = b * SEQ + nb * 128 - 128;
    LAS bf16* Ks = (LAS bf16*)lds; LAS bf16* VT = (LAS bf16*)(lds + 256 * KS_PITCH * 2);
    {
        const int row = tid >> 1, half = tid & 1; const bool valid = (nb > 0) || (row >= 128);
        v4u kv[4], vv[4];
        if (valid) { const GAS v4u* kp = (const GAS v4u*)(K + (size_t)(tok0 + row) * KVD + hk * 64 + half * 32); const GAS v4u* vp = (const GAS v4u*)(V + (size_t)(tok0 + row) * KVD + hk * 64 + half * 32);
#pragma unroll
            for (int i = 0; i < 4; ++i) { kv[i] = kp[i]; vv[i] = vp[i]; } }
        else {
#pragma unroll
            for (int i = 0; i < 4; ++i) { kv[i] = (v4u){0u, 0u, 0u, 0u}; vv[i] = (v4u){0u, 0u, 0u, 0u}; } }
#pragma unroll
        for (int i = 0; i < 4; ++i) *(LAS v4u*)(Ks + row * KS_PITCH + half * 32 + i * 8) = kv[i];
        const int pos = (row & ~12) | ((row & 4) << 1) | ((row & 8) >> 1);
#pragma unroll
        for (int i = 0; i < 4; ++i)
#pragma unroll
            for (int e = 0; e < 4; ++e) { const unsigned w = vv[i][e]; const int d = half * 32 + 8 * i + 2 * e;
                VT[d * VT_PITCH + pos] = (bf16)(w & 0xffffu); VT[(d + 1) * VT_PITCH + pos] = (bf16)(w >> 16); }
    }
    __syncthreads();
    const int head = hk * 4 + (wid >> 1);
    const float sink2 = ((const float*)a.in[I_SINKS])[head] * LOG2E;
#pragma unroll 1
    for (int qq = 0; qq < 2; ++qq) {
        const int qb = 2 * (wid & 1) + qq, q0 = 32 * qb, qi = q0 + r32;
        const size_t tokq = (size_t)(b * SEQ + nb * 128 + qi);
        bf16x8 qf[4];
#pragma unroll
        for (int ks = 0; ks < 4; ++ks) qf[ks] = *(const GAS bf16x8*)(Q + tokq * QD + head * 64 + 16 * ks + 8 * hi);
        f32x16 S[5];
#pragma unroll
        for (int t = 0; t < 5; ++t) { S[t] = (f32x16){};
#pragma unroll
            for (int ks = 0; ks < 4; ++ks) { const bf16x8 kf = *(const LAS bf16x8*)(Ks + (32 * (qb + t) + r32) * KS_PITCH + 16 * ks + 8 * hi);
                S[t] = __builtin_amdgcn_mfma_f32_32x32x16_bf16(kf, qf[ks], S[t], 0, 0, 0); } }
        float mx = sink2;
#pragma unroll
        for (int t = 0; t < 5; ++t)
#pragma unroll
            for (int r = 0; r < 16; ++r) { const int j = 32 * (qb + t) + (r & 3) + 8 * (r >> 2) + 4 * hi;
                const bool ok = (j > qi) && (j <= qi + 128) && ((nb > 0) || (j >= 128));
                S[t][r] = ok ? S[t][r] : -INFINITY; mx = fmaxf(mx, S[t][r]); }
        mx = fmaxf(mx, __shfl_xor(mx, 32));
        float sum = 0.f;
#pragma unroll
        for (int t = 0; t < 5; ++t)
#pragma unroll
            for (int r = 0; r < 16; ++r) { const float p = __builtin_amdgcn_exp2f(S[t][r] - mx); S[t][r] = p; sum += p; }
        sum += __shfl_xor(sum, 32); sum += __builtin_amdgcn_exp2f(sink2 - mx);
        const float inv = 1.f / sum;
        f32x16 Oa[2]; Oa[0] = (f32x16){}; Oa[1] = (f32x16){};
#pragma unroll
        for (int t = 0; t < 5; ++t)
#pragma unroll
            for (int s2 = 0; s2 < 2; ++s2) { bf16x8 pf; { v4u w; w.x = pk_bf16(S[t][8 * s2 + 0], S[t][8 * s2 + 1]); w.y = pk_bf16(S[t][8 * s2 + 2], S[t][8 * s2 + 3]); w.z = pk_bf16(S[t][8 * s2 + 4], S[t][8 * s2 + 5]); w.w = pk_bf16(S[t][8 * s2 + 6], S[t][8 * s2 + 7]); pf = __builtin_bit_cast(bf16x8, w); }
#pragma unroll
                for (int db = 0; db < 2; ++db) { const bf16x8 vf = *(const LAS bf16x8*)(VT + (32 * db + r32) * VT_PITCH + 32 * (qb + t) + 16 * s2 + 8 * hi);
                    Oa[db] = __builtin_amdgcn_mfma_f32_32x32x16_bf16(vf, pf, Oa[db], 0, 0, 0); } }
#pragma unroll
        for (int db = 0; db < 2; ++db)
#pragma unroll
            for (int rq = 0; rq < 4; ++rq) { v2u w; w.x = pk_bf16(Oa[db][4 * rq] * inv, Oa[db][4 * rq + 1] * inv); w.y = pk_bf16(Oa[db][4 * rq + 2] * inv, Oa[db][4 * rq + 3] * inv);
                *(GAS v2u*)(O + tokq * QD + head * 64 + 32 * db + 8 * rq + 4 * hi) = w; }
    }
    __syncthreads();
}

constexpr int BC_PITCH = 136;
template <bool S1> __device__ __forceinline__ void conv_bc(const Args& a, int t0, bool first, int g, LAS bf16* Bimg, LAS bf16* Cimg) {
    const int tid = threadIdx.x, cp = tid & 127, tq = tid >> 7;
    if (S1 && cp >= 64) return;
    const bf16* xbc = (const bf16*)(a.ws + WS_XBC); const float* cw = (const float*)a.in[I_CONVW]; const float* cb = (const float*)a.in[I_CONVB];
    const int chan = (cp < 64) ? (2048 + 128 * g + 2 * cp) : (2560 + 128 * g + 2 * (cp - 64));
    float w[4][2], bias[2];
#pragma unroll
    for (int k = 0; k < 4; ++k) { w[k][0] = cw[k * CONVD + chan]; w[k][1] = cw[k * CONVD + chan + 1]; }
    bias[0] = cb[chan]; bias[1] = cb[chan + 1];
    const int l0 = 32 * tq;
    unsigned xin[35];
#pragma unroll
    for (int i = 0; i < 35; ++i) { const int l = l0 - 3 + i; xin[i] = (first && l < 0) ? 0u : *(const GAS unsigned*)(xbc + (size_t)(t0 + l) * CONVD + chan); }
#pragma unroll
    for (int l = 0; l < 32; ++l) {
        float o0 = bias[0], o1 = bias[1];
#pragma unroll
        for (int k = 0; k < 4; ++k) { o0 += w[k][0] * bf_lo(xin[l + k]); o1 += w[k][1] * bf_hi(xin[l + k]); }
        o0 = silu_f(o0); o1 = silu_f(o1);
        if (S1) { const unsigned pk = pk_bf16(o0, o1); Bimg[(2 * cp) * BC_PITCH + l0 + l] = (bf16)(pk & 0xffffu); Bimg[(2 * cp + 1) * BC_PITCH + l0 + l] = (bf16)(pk >> 16); }
        else { LAS bf16* img = (cp < 64) ? Bimg : Cimg; *(LAS unsigned*)(img + (l0 + l) * BC_PITCH + 2 * (cp & 63)) = pk_bf16(o0, o1); }
    }
}
template <int NT> __device__ __forceinline__ void conv_x(const bf16* xcol  , int l, bool first, const float (&w)[4], float bias, float (&out)[NT]) {
    float xin[NT + 3];
#pragma unroll
    for (int i = 0; i < NT + 3; ++i) { const int ll = l - 3 + i; xin[i] = (first && ll < 0) ? 0.f : bf2f(*(const GAS bf16*)(xcol + (ptrdiff_t)ll * CONVD)); }
#pragma unroll
    for (int j = 0; j < NT; ++j) out[j] = silu_f(bias + w[0] * xin[j] + w[1] * xin[j + 1] + w[2] * xin[j + 2] + w[3] * xin[j + 3]);
}

__device__ __forceinline__ void ssd_states_unit(const Args& a, LAS unsigned char* lds, int unit) {
    const int tid = threadIdx.x, lane = tid & 63, wid = __builtin_amdgcn_readfirstlane(tid >> 6), r32 = lane & 31, hi = lane >> 5;
    const int g = unit & 3, c = (unit >> 2) & 15, b = unit >> 6, t0 = b * SEQ + c * 128; const bool first = (c == 0);
    LAS bf16* BT = (LAS bf16*)lds; LAS float* wv = (LAS float*)(lds + 128 * BC_PITCH * 2) + wid * 128;
    conv_bc<true>(a, t0, first, g, BT, nullptr);
    const int hh = 8 * g + wid;
    const float* dtp = (const float*)(a.ws + WS_DT); float* acsg = (float*)(a.ws + WS_ACS);
    const float aneg = -expf(((const float*)a.in[I_ALOG])[hh]);
    {
        const float d0 = dtp[(size_t)(t0 + lane) * NH + hh], d1 = dtp[(size_t)(t0 + 64 + lane) * NH + hh];
        float c0 = d0 * aneg, c1 = d1 * aneg;
#pragma unroll
        for (int o = 1; o < 64; o <<= 1) { const float u0 = __shfl_up(c0, o), u1 = __shfl_up(c1, o); if (lane >= o) { c0 += u0; c1 += u1; } }
        c1 += __shfl(c0, 63); const float tot = __shfl(c1, 63);
        acsg[(size_t)(t0 + lane) * NH + hh] = c0; acsg[(size_t)(t0 + 64 + lane) * NH + hh] = c1;
        wv[lane] = d0 * expf(tot - c0); wv[lane + 64] = d1 * expf(tot - c1);
    }
    __syncthreads();
    const bf16* xbc = (const bf16*)(a.ws + WS_XBC); const float* cw = (const float*)a.in[I_CONVW]; const float* cb = (const float*)a.in[I_CONVB];
    float* st = (float*)(a.ws + WS_STATES) + (size_t)((b * NCH + c) * NH + hh) * 8192;
#pragma unroll 1
    for (int pb = 0; pb < 2; ++pb) {
        const int ch = hh * 64 + 32 * pb + r32;
        float w[4]; for (int k = 0; k < 4; ++k) w[k] = cw[k * CONVD + ch]; const float bias = cb[ch];
        const bf16* xcol = xbc + (size_t)t0 * CONVD + ch;
        f32x16 acc[4]; for (int i = 0; i < 4; ++i) acc[i] = (f32x16){};
#pragma unroll 2
        for (int ks = 0; ks < 8; ++ks) {
            const int lb = 16 * ks + 8 * hi; float xv[8]; conv_x<8>(xcol, lb, first, w, bias, xv);
            const f32x4 w0 = *(const LAS f32x4*)(wv + lb), w1 = *(const LAS f32x4*)(wv + lb + 4);
            v4u pw; pw.x = pk_bf16(xv[0] * w0[0], xv[1] * w0[1]); pw.y = pk_bf16(xv[2] * w0[2], xv[3] * w0[3]); pw.z = pk_bf16(xv[4] * w1[0], xv[5] * w1[1]); pw.w = pk_bf16(xv[6] * w1[2], xv[7] * w1[3]);
            const bf16x8 bfr = __builtin_bit_cast(bf16x8, pw);
#pragma unroll
            for (int nb = 0; nb < 4; ++nb) { const bf16x8 af = *(const LAS bf16x8*)(BT + (32 * nb + r32) * BC_PITCH + lb); acc[nb] = __builtin_amdgcn_mfma_f32_32x32x16_bf16(af, bfr, acc[nb], 0, 0, 0); }
        }
#pragma unroll
        for (int nb = 0; nb < 4; ++nb)
#pragma unroll
            for (int rq = 0; rq < 4; ++rq) *(GAS f32x4*)(st + (size_t)(32 * pb + r32) * 128 + 32 * nb + 8 * rq + 4 * hi) = (f32x4){acc[nb][4 * rq], acc[nb][4 * rq + 1], acc[nb][4 * rq + 2], acc[nb][4 * rq + 3]};
    }
    __syncthreads();
}

__device__ __forceinline__ void ssd_scan(const Args& a, int vcu, int G) {
    const float* st = (const float*)(a.ws + WS_STATES); bf16* prev = (bf16*)(a.ws + WS_PREV); const float* acsg = (const float*)(a.ws + WS_ACS);
    const int gt = vcu * NTHREADS + threadIdx.x, NGT = G * NTHREADS;
    for (int i = gt; i < BATCH * NH * 2048; i += NGT) {
        const int e4 = i & 2047, hh = (i >> 11) & 31, b = i >> 16;
        f32x4 carry = (f32x4){0.f, 0.f, 0.f, 0.f};
#pragma unroll 4
        for (int c = 0; c < NCH; ++c) { const size_t off = (size_t)((b * NCH + c) * NH + hh) * 8192 + 4 * e4;
            const f32x4 s = *(const GAS f32x4*)(st + off); const float dec = expf(acsg[(size_t)(b * SEQ + c * 128 + 127) * NH + hh]);
            v2u w; w.x = pk_bf16(carry[0], carry[1]); w.y = pk_bf16(carry[2], carry[3]); *(GAS v2u*)(prev + off) = w;
            carry = carry * dec + s; }
    }
}

constexpr int S3_XF = 2 * 128 * BC_PITCH * 2, S3_TAB = S3_XF + 4 * 16384, S3_SSQ = S3_TAB + 4 * 1024, S3_END = S3_SSQ + 4 * 128 * 4;
__device__ __forceinline__ void ssd_out_unit(const Args& a, LAS unsigned char* lds, int unit) {
    const int tid = threadIdx.x, lane = tid & 63, wid = __builtin_amdgcn_readfirstlane(tid >> 6), r32 = lane & 31, hi = lane >> 5;
    const int hhalf = unit & 1, g = (unit >> 1) & 3, c = (unit >> 3) & 15, b = unit >> 7, t0 = b * SEQ + c * 128; const bool first = (c == 0);
    const int hl = wid >> 1, role = wid & 1, hh = 8 * g + 4 * hhalf + hl;
    LAS bf16* Bs = (LAS bf16*)lds; LAS bf16* Cs = Bs + 128 * BC_PITCH;
    LAS unsigned char* XF = lds + S3_XF + hl * 16384;
    LAS float* acsw = (LAS float*)(lds + S3_TAB) + hl * 256; LAS float* dtw = acsw + 128;
    LAS float* ssqx = (LAS float*)(lds + S3_SSQ);
    conv_bc<false>(a, t0, first, g, Bs, Cs);
    { const float* dtp = (const float*)(a.ws + WS_DT); const float* acsg = (const float*)(a.ws + WS_ACS); const int l = lane + 64 * role;
      acsw[l] = acsg[(size_t)(t0 + l) * NH + hh]; dtw[l] = dtp[(size_t)(t0 + l) * NH + hh]; }
    {
        const bf16* xbc = (const bf16*)(a.ws + WS_XBC); const float* cw = (const float*)a.in[I_CONVW]; const float* cb = (const float*)a.in[I_CONVB];
        const int ch = hh * 64 + 32 * role + r32;
        float w[4]; for (int k = 0; k < 4; ++k) w[k] = cw[k * CONVD + ch]; const float bias = cb[ch];
        const bf16* xcol = xbc + (size_t)t0 * CONVD + ch;
#pragma unroll
        for (int sb = 0; sb < 4; ++sb) {
#pragma unroll
            for (int s2 = 0; s2 < 2; ++s2) { const int l = 32 * sb + 16 * s2 + 4 * hi; float x0[4], x1[4]; conv_x<4>(xcol, l, first, w, bias, x0); conv_x<4>(xcol, l + 8, false, w, bias, x1);
                v4u pw; pw.x = pk_bf16(x0[0], x0[1]); pw.y = pk_bf16(x0[2], x0[3]); pw.z = pk_bf16(x1[0], x1[1]); pw.w = pk_bf16(x1[2], x1[3]);
                *(LAS v4u*)(XF + ((role * 4 + sb) * 2 + s2) * 1024 + lane * 16) = pw; }
            if (sb & 1) asm volatile("" ::: "memory"); }
    }
    __syncthreads();
    const float Dh = ((const float*)a.in[I_DSKIP])[hh];
    const bf16* prev = (const bf16*)(a.ws + WS_PREV) + (size_t)((b * NCH + c) * NH + hh) * 8192;
    const bf16* sz = (const bf16*)(a.ws + WS_SZ); bf16* yp = (bf16*)(a.ws + WS_YP);
#pragma unroll 1
    for (int it = 0; it < 2; ++it) {
        const int lb = role ? 1 + it : 3 * it;
        const int l = 32 * lb + r32; const float acs_l = acsw[l];
        bf16x8 Cf[8];
#pragma unroll
        for (int ks = 0; ks < 8; ++ks) Cf[ks] = *(const LAS bf16x8*)(Cs + l * BC_PITCH + 16 * ks + 8 * hi);
        f32x16 Y[2]; Y[0] = (f32x16){}; Y[1] = (f32x16){};
        if (!first) {
#pragma unroll
            for (int ks = 0; ks < 8; ++ks)
#pragma unroll
                for (int pb = 0; pb < 2; ++pb) { const bf16x8 pf = *(const GAS bf16x8*)(prev + (size_t)(32 * pb + r32) * 128 + 16 * ks + 8 * hi); Y[pb] = __builtin_amdgcn_mfma_f32_32x32x16_bf16(pf, Cf[ks], Y[pb], 0, 0, 0); }
            const float el = __builtin_amdgcn_exp2f(acs_l * LOG2E);
            Y[0] = Y[0] * el; Y[1] = Y[1] * el;
        }
#pragma unroll 1
        for (int sb = 0; sb <= lb; ++sb) {
            f32x16 cbt = (f32x16){};
#pragma unroll
            for (int ks = 0; ks < 8; ++ks) { const bf16x8 bfr = *(const LAS bf16x8*)(Bs + (32 * sb + r32) * BC_PITCH + 16 * ks + 8 * hi); cbt = __builtin_amdgcn_mfma_f32_32x32x16_bf16(bfr, Cf[ks], cbt, 0, 0, 0); }
            float gv[16];
#pragma unroll
            for (int rq = 0; rq < 4; ++rq) { const int s0 = 32 * sb + 8 * rq + 4 * hi; const f32x4 as = *(const LAS f32x4*)(acsw + s0), ds = *(const LAS f32x4*)(dtw + s0);
#pragma unroll
                for (int e = 0; e < 4; ++e) { float v = cbt[4 * rq + e] * ds[e] * __builtin_amdgcn_exp2f((acs_l - as[e]) * LOG2E);
                    const int s = s0 + e; v = (s > l) ? 0.f : v; v = (s == l) ? v + Dh : v;
                    gv[4 * rq + e] = v; } }
#pragma unroll
            for (int s2 = 0; s2 < 2; ++s2) { v4u pw; pw.x = pk_bf16(gv[8 * s2 + 0], gv[8 * s2 + 1]); pw.y = pk_bf16(gv[8 * s2 + 2], gv[8 * s2 + 3]); pw.z = pk_bf16(gv[8 * s2 + 4], gv[8 * s2 + 5]); pw.w = pk_bf16(gv[8 * s2 + 6], gv[8 * s2 + 7]);
                const bf16x8 gf = __builtin_bit_cast(bf16x8, pw);
                const bf16x8 x0 = *(const LAS bf16x8*)(XF + ((0 * 4 + sb) * 2 + s2) * 1024 + lane * 16), x1 = *(const LAS bf16x8*)(XF + ((1 * 4 + sb) * 2 + s2) * 1024 + lane * 16);
                Y[0] = __builtin_amdgcn_mfma_f32_32x32x16_bf16(x0, gf, Y[0], 0, 0, 0); Y[1] = __builtin_amdgcn_mfma_f32_32x32x16_bf16(x1, gf, Y[1], 0, 0, 0); }
        }
        const size_t tok = (size_t)(t0 + l); float ssq = 0.f;
#pragma unroll
        for (int pb = 0; pb < 2; ++pb)
#pragma unroll
            for (int rq = 0; rq < 4; ++rq) { const size_t off = tok * DI + hh * 64 + 32 * pb + 8 * rq + 4 * hi; const v2u zz = *(const GAS v2u*)(sz + off);
                const float y0 = Y[pb][4 * rq] * bf_lo(zz.x), y1 = Y[pb][4 * rq + 1] * bf_hi(zz.x), y2 = Y[pb][4 * rq + 2] * bf_lo(zz.y), y3 = Y[pb][4 * rq + 3] * bf_hi(zz.y);
                ssq += (y0 * y0 + y1 * y1) + (y2 * y2 + y3 * y3);
                v2u w; w.x = pk_bf16(y0, y1); w.y = pk_bf16(y2, y3); *(GAS v2u*)(yp + off) = w; }
        ssq += __shfl_xor(ssq, 32);
        if (hi == 0) ssqx[hl * 128 + l] = ssq;
    }
    __syncthreads();
    if (tid < 128) { const float s = (ssqx[tid] + ssqx[128 + tid]) + (ssqx[256 + tid] + ssqx[384 + tid]);
        ((float*)(a.ws + WS_SSQ))[(size_t)(t0 + tid) * 8 + 2 * g + hhalf] = s; }
    __syncthreads();
}

__device__ __forceinline__ void final_norm(const Args& a, int vcu, int G) {
    const int tid = threadIdx.x, lane = tid & 63, wave = tid >> 6; const int gw = vcu * NWAVES + wave, NGW = G * NWAVES;
    const float* ss3 = (const float*)(a.ws + WS_SS3); const GAS f32x4* gf = (const GAS f32x4*)a.in[I_GFIN] + lane;
    for (int m = gw; m < M; m += NGW) {
        const f32x4 s0 = *(const GAS f32x4*)(ss3 + (size_t)m * 8), s1 = *(const GAS f32x4*)(ss3 + (size_t)m * 8 + 4);
        const float r = rsqrtf((((s0[0] + s0[1]) + (s0[2] + s0[3])) + ((s1[0] + s1[1]) + (s1[2] + s1[3]))) * (1.f / DM) + 1e-6f);
        GAS f32x4* o = (GAS f32x4*)(a.out + (size_t)m * DM) + lane;
#pragma unroll
        for (int j = 0; j < 8; ++j) { f32x4 v = o[64 * j]; const f32x4 gg = gf[64 * j]; v = v * gg * r; o[64 * j] = v; }
    }
}

__global__ void __launch_bounds__(NTHREADS, 2) mk_fwd(Args args) {
    extern __shared__ __attribute__((aligned(16))) unsigned char lds_raw[];
    LAS unsigned char* lds = (LAS unsigned char*)lds_raw;
    volatile LAS unsigned* MISC = (volatile LAS unsigned*)(lds + MISC_OFF);
    const int tid = threadIdx.x;
    const int G = gridDim.x; const int bx = blockIdx.x; const int vcu = (G % 8 == 0) ? (bx % 8) * (G / 8) + bx / 8 : bx;
    unsigned char* ws = args.ws;
    for (int u = tid; u < 64; u += NTHREADS) MISC[u] = 0u;
    __syncthreads();
    XcdBarrier bar; bar.bar = (unsigned*)(ws + WS_CTL) + CW_BAR; bar.x = 0; bar.st = nullptr;
    if (MK_N_LAUNCHES == 1) bar = xcd_barrier_post((unsigned*)(ws + WS_CTL) + CW_BAR, MISC + 8);
    const int lo = args.ph_lo, hi = args.ph_hi;
#ifndef PHMASK
#define PHMASK 0x7ff
#endif
#define IN(k) (((PHMASK >> (k)) & 1) && lo <= (k) && (k) < hi)
#define SEAM(k) do { if (IN(k) && IN((k) + 1)) { if ((k) == 0) cg::this_grid().sync(); else xcd_barrier(bar); } } while (0)
    using pg8::Gemm; using pg8::StaticOrder; using pg8::gemm_phase; using pg8::EpiProj; using pg8::EpiGateA; using pg8::EpiGateS; using pg8::EpiRes; using pg8::EpiGU; using pg8::EpiF32; using pg8::bf16_t;
    PG8_LAS unsigned char* ring = (PG8_LAS unsigned char*)lds;
    PG8_LAS float* xl = (PG8_LAS float*)(lds + XLDS_OFF);

    if (IN(0)) { p0_prologue(args, lds, vcu, G); }
    SEAM(0);
    if (IN(1)) {
        Gemm g{(const bf16_t*)(ws + WS_U), (const bf16_t*)(ws + WS_WIN), M, NINP, DM}; StaticOrder S; S.init(M, NINP, G, bx);
        EpiProj E{(bf16_t*)(ws + WS_Q), (bf16_t*)(ws + WS_K), (bf16_t*)(ws + WS_V), (bf16_t*)(ws + WS_SZ), (bf16_t*)(ws + WS_XBC), (bf16_t*)args.out, (bf16_t*)args.out + (size_t)M * DM,
                  (float*)(ws + WS_DT), (const float*)(ws + WS_CS), (const float*)args.in[I_DTB]};
        gemm_phase<EpiProj, StaticOrder, true, true>(ring, g, S, E);
    }
    SEAM(1);
    if (IN(2)) {
        for (int u = vcu; u < BATCH * NCH * 4; u += G) attn_unit(args, lds, u);
        for (int u = vcu; u < BATCH * NCH * 4; u += G) ssd_states_unit(args, lds, u);
    }
    SEAM(2);
    if (IN(3)) { ssd_scan(args, vcu, G); }
    SEAM(3);
    if (IN(4)) { static_assert(S3_END <= MISC_OFF, "S3 LDS"); for (int u = vcu; u < BATCH * NCH * 8; u += G) ssd_out_unit(args, lds, u); }
    SEAM(4);
    if (IN(5)) {
        { Gemm g{(const bf16_t*)(ws + WS_ATTN), (const bf16_t*)(ws + WS_WATTN), M, DM, QD}; StaticOrder S; S.init(M, DM, G, bx);
          EpiGateA E{(const bf16_t*)args.out, (float*)(ws + WS_TMP)};
          gemm_phase<EpiGateA, StaticOrder, true, true>(ring, g, S, E); }
        { Gemm g{(const bf16_t*)(ws + WS_YP), (const bf16_t*)(ws + WS_WSSD), M, DM, DI}; StaticOrder S; S.init(M, DM, G, bx);
          EpiGateS E{(const bf16_t*)args.out + (size_t)M * DM, (const float*)(ws + WS_TMP), (const float*)(ws + WS_SSQ), (bf16_t*)(ws + WS_MERGED)};
          gemm_phase<EpiGateS, StaticOrder, true, true>(ring, g, S, E); }
    }
    SEAM(5);
    if (IN(6)) {
        Gemm g{(const bf16_t*)(ws + WS_MERGED), (const bf16_t*)(ws + WS_WO), M, DM, DM}; StaticOrder S; S.init(M, DM, G, bx);
        EpiRes<0> E{(const float*)args.in[I_X], args.out, (bf16_t*)(ws + WS_H1B), (float*)(ws + WS_SS1), nullptr, nullptr, xl, 0.f};
        gemm_phase<EpiRes<0>, StaticOrder, true, true>(ring, g, S, E);
    }
    SEAM(6);
    if (IN(7)) {
        Gemm g{(const bf16_t*)(ws + WS_H1B), (const bf16_t*)(ws + WS_WGU), M, 2 * FF, DM}; StaticOrder S; S.init(M, 2 * FF, G, bx);
        EpiGU E{(const float*)(ws + WS_SS1), (bf16_t*)(ws + WS_ACT), 1e-6f};
        gemm_phase<EpiGU, StaticOrder, true, true>(ring, g, S, E);
    }
    SEAM(7);
    if (IN(8)) {
        Gemm g{(const bf16_t*)(ws + WS_ACT), (const bf16_t*)(ws + WS_WDOWN), M, DM, FF}; StaticOrder S; S.init(M, DM, G, bx);
        EpiRes<0> E{args.out, args.out, (bf16_t*)(ws + WS_H2B), (float*)(ws + WS_SS2), nullptr, nullptr, xl, 0.f};
        gemm_phase<EpiRes<0>, StaticOrder, true, true>(ring, g, S, E);
    }
    SEAM(8);
    if (IN(9)) {
        { int kp = PLE; asm volatile("" : "+s"(kp));
          Gemm g{(const bf16_t*)(ws + WS_PB), (const bf16_t*)(ws + WS_WPP), M, DM, kp}; StaticOrder S; S.init(M, DM, G, bx);
          EpiF32 E{(float*)(ws + WS_TMP)};
          gemm_phase<EpiF32, StaticOrder, true, true>(ring, g, S, E); }
        { Gemm g{(const bf16_t*)(ws + WS_H2B), (const bf16_t*)(ws + WS_WPG), M, DM, DM}; StaticOrder S; S.init(M, DM, G, bx);
          EpiRes<1> E{args.out, args.out, nullptr, (float*)(ws + WS_SS3), (const float*)(ws + WS_SS2), (const float*)(ws + WS_TMP), xl, 1e-6f};
          gemm_phase<EpiRes<1>, StaticOrder, true, true>(ring, g, S, E); }
    }
    SEAM(9);
    if (IN(10)) { final_norm(args, vcu, G); }
#undef IN
#undef SEAM
}

extern "C" void kernel_launch(void* const* d_in, const int* in_sizes, int n_in, void* d_out, int out_size, void* d_ws, size_t ws_size, hipStream_t stream) {
    static int grid = 0;
    if (grid == 0) {
        if (n_in != N_IN || in_sizes[0] != M * DM || out_size != M * DM || ws_size < WS_END) {
            fprintf(stderr, "kernel_launch: shape/workspace mismatch (n_in %d, in0 %d, out %d, ws %zu, need %zu); nothing launched\n", n_in, n_in > 0 ? in_sizes[0] : -1, out_size, ws_size, (size_t)WS_END); grid = -1; return; }
        int dev = 0, cus = 0, per_cu = 0;
        hipGetDevice(&dev); hipDeviceGetAttribute(&cus, hipDeviceAttributeMultiprocessorCount, dev);
        if (hipFuncSetAttribute((const void*)mk_fwd, hipFuncAttributeMaxDynamicSharedMemorySize, LDS_BYTES) != hipSuccess) { fprintf(stderr, "kernel_launch: hipFuncSetAttribute failed\n"); grid = -1; return; }
        if (hipOccupancyMaxActiveBlocksPerMultiprocessor(&per_cu, (const void*)mk_fwd, NTHREADS, LDS_BYTES) != hipSuccess || per_cu < 1) { fprintf(stderr, "kernel_launch: occupancy query failed (%d)\n", per_cu); (void)hipGetLastError(); per_cu = 1; }
        grid = cus * (per_cu >= 1 ? 1 : 1);
        fprintf(stderr, "kernel_launch: cus %d per_cu %d grid %d ws %zu\n", cus, per_cu, grid, ws_size);
    }
    if (grid < 0) return;
    hipMemsetAsync((char*)d_ws + WS_CTL, 0, CTL_ZERO_BYTES, stream);
    Args a{};
    for (int i = 0; i < N_IN; ++i) a.in[i] = d_in[i];
    a.out = (float*)d_out; a.ws = (unsigned char*)d_ws;
#if MK_N_LAUNCHES == 1
    a.ph_lo = 0; a.ph_hi = NPHASE;
    void* kargs[] = {&a};
    hipError_t e = hipLaunchCooperativeKernel((const void*)mk_fwd, dim3(grid), dim3(NTHREADS), kargs, LDS_BYTES, stream);
    if (e != hipSuccess) fprintf(stderr, "kernel_launch: cooperative launch failed: %s (grid %d)\n", hipGetErrorString(e), grid);
#else
    for (int ph = 0; ph < NPHASE; ++ph) { a.ph_lo = ph; a.ph_hi = ph + 1; hipLaunchKernelGGL(mk_fwd, dim3(grid), dim3(NTHREADS), LDS_BYTES, stream, a); }
#endif
}
```

```cpp
#include <hip/hip_runtime.h>
#include <hip/hip_cooperative_groups.h>
#include <cstdio>
#include <cstdint>
namespace cg = cooperative_groups;
namespace pg8 {
#define PG8_LAS __attribute__((address_space(3)))
typedef unsigned short bf16_t;
typedef short bf16x8 __attribute__((ext_vector_type(8)));
typedef float f32x4 __attribute__((ext_vector_type(4)));
typedef unsigned u32x4 __attribute__((ext_vector_type(4)));
constexpr int BM = 256, BK = 64, HALF = 128, HTB = HALF * BK * 2  , STAGE_BYTES = 8 * HTB, NXCD = 8, WGM = 8;

__host__ __device__ __forceinline__ int lds_byte(int r, int c) { const int st = (r >> 4) * 2 + (c >> 5), rr = r & 15, cc = c & 31, ob = rr * 64 + cc * 2; return st * 1024 + (ob ^ (((ob >> 9) & 1) << 5)); }
__host__ __device__ __forceinline__ void stage_rc(int b, int& R, int& C) { const int st = b / 1024, sb = b % 1024, swz = sb ^ (((sb >> 9) & 1) << 5); R = (st >> 1) * 16 + swz / 64; C = (st & 1) * 32 + (swz % 64) / 2; }
__host__ __device__ __forceinline__ int perm32(int rho) { const int n = rho >> 4, i = rho & 15; return 8 * (i >> 2) + 4 * n + (i & 3); }

struct Unit { int pm, pn; };
struct Gemm { const bf16_t* A; const bf16_t* Bt; int M, N, K; };

struct StaticOrder {
    int nM, nN, nwg, G, c;
    __host__ __device__ void init(int M, int N, int G_, int c_) { nM = M / BM; nN = N / BM; nwg = nM * nN; G = G_; c = c_; }
    __host__ __device__ bool next(int i, Unit& u) const {
        const long L = (long)i * G + c; if (L >= nwg) return false;
        int wgid = (int)L; { const int q = nwg / NXCD, r = nwg % NXCD, xcd = wgid % NXCD, off = wgid / NXCD; wgid = (xcd < r ? xcd * (q + 1) : r * (q + 1) + (xcd - r) * q) + off; }
        const int nig = WGM * nN, gid = wgid / nig, fm = gid * WGM, gsz = (nM - fm) < WGM ? (nM - fm) : WGM;
        u.pm = fm + ((wgid % nig) % gsz); u.pn = (wgid % nig) / gsz; return true;
    }
    __device__ __forceinline__ void a_ready(const Unit&) const {}
    __device__ __forceinline__ void done(const Unit&) const {}
};


typedef unsigned u32x2 __attribute__((ext_vector_type(2)));
typedef float f32x2v __attribute__((ext_vector_type(2)));
typedef __bf16 bf16x2v __attribute__((ext_vector_type(2)));
__device__ __forceinline__ unsigned pk_bf16(float lo, float hi) { f32x2v v = {lo, hi}; bf16x2v b = __builtin_convertvector(v, bf16x2v); return __builtin_bit_cast(unsigned, b); }
__device__ __forceinline__ float bf_lo(unsigned u) { return __uint_as_float(u << 16); }
__device__ __forceinline__ float bf_hi(unsigned u) { return __uint_as_float(u & 0xffff0000u); }
__device__ __forceinline__ float sigmoid_f(float x) { return __builtin_amdgcn_rcpf(1.f + __expf(-x)); }
__device__ __forceinline__ float silu_f(float x) { return x * sigmoid_f(x); }
__device__ __forceinline__ float softplus_f(float x) { return x > 20.f ? x : log1pf(expf(x)); }
constexpr float QSCALE = 0.125f * 1.4426950408889634f;


struct EpiProj {
    static constexpr bool PERM = true, AFTER_DRAIN = false;
    bf16_t *q, *k, *v, *sz, *xbc, *ga, *gs; float* dt; const float* cs; const float* dt_bias;
    template <int MODE> __device__ __forceinline__ void plain(const f32x4 (&acc)[2][2][4][2], bf16_t* dst, int ld, int row0, int cw) const {
#pragma unroll
        for (int ai = 0; ai < 2; ++ai)
#pragma unroll
            for (int m = 0; m < 4; ++m) { bf16_t* rowp = dst + (size_t)(row0 + ai * HALF + m * 16) * ld + cw;
#pragma unroll
                for (int bj = 0; bj < 2; ++bj) { f32x4 v0 = acc[ai][bj][m][0], v1 = acc[ai][bj][m][1];
                    if (MODE == 1) { for (int e = 0; e < 4; ++e) { v0[e] = silu_f(v0[e]); v1[e] = silu_f(v1[e]); } }
                    if (MODE == 2) { for (int e = 0; e < 4; ++e) { v0[e] = sigmoid_f(v0[e]); v1[e] = sigmoid_f(v1[e]); } }
                    u32x4 w; w.x = pk_bf16(v0[0], v0[1]); w.y = pk_bf16(v0[2], v0[3]); w.z = pk_bf16(v1[0], v1[1]); w.w = pk_bf16(v1[2], v1[3]);
                    *(u32x4*)(rowp + bj * HALF) = w; } }
    }
    __device__ __forceinline__ void operator()(const f32x4 (&acc)[2][2][4][2], const Unit& u, int wr, int wc, int fr, int fq) const {
        const int pn = u.pn, row0 = u.pm * BM + wr * 64 + fr, cw = wc * 32 + 8 * fq;
        if (pn < 5) {
            bf16_t* dst = pn < 4 ? q + pn * 256 : k; const int ld = pn < 4 ? 1024 : 256; const float sc = pn < 4 ? QSCALE : 1.f;
            const int i0 = (wc & 1) * 16 + 4 * fq;
#pragma unroll
            for (int ai = 0; ai < 2; ++ai)
#pragma unroll
                for (int m = 0; m < 4; ++m) { const int row = row0 + ai * HALF + m * 16;
                    const f32x4* t = (const f32x4*)(cs + ((size_t)row * 32 + i0) * 2); const f32x4 t0 = t[0], t1 = t[1];
#pragma unroll
                    for (int bj = 0; bj < 2; ++bj) { const f32x4 v0 = acc[ai][bj][m][0], v1 = acc[ai][bj][m][1];
                        const float o0 = (v0[0] * t0[0] - v0[1] * t0[1]) * sc, o1 = (v0[1] * t0[0] + v0[0] * t0[1]) * sc;
                        const float o2 = (v0[2] * t0[2] - v0[3] * t0[3]) * sc, o3 = (v0[3] * t0[2] + v0[2] * t0[3]) * sc;
                        const float o4 = (v1[0] * t1[0] - v1[1] * t1[1]) * sc, o5 = (v1[1] * t1[0] + v1[0] * t1[1]) * sc;
                        const float o6 = (v1[2] * t1[2] - v1[3] * t1[3]) * sc, o7 = (v1[3] * t1[2] + v1[2] * t1[3]) * sc;
                        u32x4 w; w.x = pk_bf16(o0, o1); w.y = pk_bf16(o2, o3); w.z = pk_bf16(o4, o5); w.w = pk_bf16(o6, o7);
                        *(u32x4*)(dst + (size_t)row * ld + bj * HALF + cw) = w; } }
        } else if (pn == 5) plain<0>(acc, v, 256, row0, cw);
        else if (pn < 14) plain<1>(acc, sz + (pn - 6) * 256, 2048, row0, cw);
        else if (pn < 26) plain<0>(acc, xbc + (pn - 14) * 256, 3072, row0, cw);
        else if (pn < 34) plain<2>(acc, ga + (pn - 26) * 256, 2048, row0, cw);
        else if (pn < 42) plain<2>(acc, gs + (pn - 34) * 256, 2048, row0, cw);
        else if (wc == 0) {
            const f32x4 b0 = *(const f32x4*)(dt_bias + 8 * fq), b1 = *(const f32x4*)(dt_bias + 8 * fq + 4);
#pragma unroll
            for (int ai = 0; ai < 2; ++ai)
#pragma unroll
                for (int m = 0; m < 4; ++m) { float* rowp = dt + (size_t)(row0 + ai * HALF + m * 16) * 32 + 8 * fq;
                    f32x4 v0 = acc[ai][0][m][0] + b0, v1 = acc[ai][0][m][1] + b1;
                    for (int e = 0; e < 4; ++e) { v0[e] = softplus_f(v0[e]); v1[e] = softplus_f(v1[e]); }
                    *(f32x4*)rowp = v0; *(f32x4*)(rowp + 4) = v1; }
        }
    }
};

struct EpiGateA {
    static constexpr bool PERM = true, AFTER_DRAIN = false;
    const bf16_t* ga; float* tmp;
    __device__ __forceinline__ void operator()(const f32x4 (&acc)[2][2][4][2], const Unit& u, int wr, int wc, int fr, int fq) const {
        const int row0 = u.pm * BM + wr * 64 + fr, col0 = u.pn * BM + wc * 32 + 8 * fq;
#pragma unroll
        for (int ai = 0; ai < 2; ++ai)
#pragma unroll
            for (int m = 0; m < 4; ++m) { const size_t off = (size_t)(row0 + ai * HALF + m * 16) * 2048 + col0;
#pragma unroll
                for (int bj = 0; bj < 2; ++bj) { const u32x4 g = *(const u32x4*)(ga + off + bj * HALF);
                    f32x4 v0 = acc[ai][bj][m][0], v1 = acc[ai][bj][m][1];
                    v0[0] *= bf_lo(g.x); v0[1] *= bf_hi(g.x); v0[2] *= bf_lo(g.y); v0[3] *= bf_hi(g.y); v1[0] *= bf_lo(g.z); v1[1] *= bf_hi(g.z); v1[2] *= bf_lo(g.w); v1[3] *= bf_hi(g.w);
                    *(f32x4*)(tmp + off + bj * HALF) = v0; *(f32x4*)(tmp + off + bj * HALF + 4) = v1; } }
    }
};
struct EpiGateS {
    static constexpr bool PERM = true, AFTER_DRAIN = false;
    const bf16_t* gs; const float* tmp; const float* ssq; bf16_t* merged;
    __device__ __forceinline__ void operator()(const f32x4 (&acc)[2][2][4][2], const Unit& u, int wr, int wc, int fr, int fq) const {
        const int row0 = u.pm * BM + wr * 64 + fr, col0 = u.pn * BM + wc * 32 + 8 * fq;
#pragma unroll
        for (int ai = 0; ai < 2; ++ai)
#pragma unroll
            for (int m = 0; m < 4; ++m) { const int row = row0 + ai * HALF + m * 16; const size_t off = (size_t)row * 2048 + col0;
                const f32x4 s4 = *(const f32x4*)(ssq + (size_t)row * 8), s5 = *(const f32x4*)(ssq + (size_t)row * 8 + 4);
                const float r = rsqrtf((((s4[0] + s4[1]) + (s4[2] + s4[3])) + ((s5[0] + s5[1]) + (s5[2] + s5[3]))) * (1.f / 2048.f) + 1e-5f);
#pragma unroll
                for (int bj = 0; bj < 2; ++bj) { const u32x4 g = *(const u32x4*)(gs + off + bj * HALF);
                    const f32x4 t0 = *(const f32x4*)(tmp + off + bj * HALF), t1 = *(const f32x4*)(tmp + off + bj * HALF + 4);
                    f32x4 v0 = acc[ai][bj][m][0] * r, v1 = acc[ai][bj][m][1] * r;
                    v0[0] = t0[0] + v0[0] * bf_lo(g.x); v0[1] = t0[1] + v0[1] * bf_hi(g.x); v0[2] = t0[2] + v0[2] * bf_lo(g.y); v0[3] = t0[3] + v0[3] * bf_hi(g.y);
                    v1[0] = t1[0] + v1[0] * bf_lo(g.z); v1[1] = t1[1] + v1[1] * bf_hi(g.z); v1[2] = t1[2] + v1[2] * bf_lo(g.w); v1[3] = t1[3] + v1[3] * bf_hi(g.w);
                    u32x4 w; w.x = pk_bf16(v0[0], v0[1]); w.y = pk_bf16(v0[2], v0[3]); w.z = pk_bf16(v1[0], v1[1]); w.w = pk_bf16(v1[2], v1[3]);
                    *(u32x4*)(merged + off + bj * HALF) = w; } }
    }
};
template <int MODE> struct EpiRes {
    static constexpr bool PERM = false, AFTER_DRAIN = false;
    const float* res; float* out; bf16_t* hb; float* ss; const float* ssin; const float* tmp; PG8_LAS float* xlds; float eps;
    __device__ __forceinline__ void operator()(const f32x4 (&acc)[2][2][4][2], const Unit& u, int wr, int wc, int fr, int fq) const {
        const int row0 = u.pm * BM + wr * 64 + fr, col0 = u.pn * BM + wc * 32 + 4 * fq;
#pragma unroll
        for (int ai = 0; ai < 2; ++ai)
#pragma unroll
            for (int m = 0; m < 4; ++m) { const int row = row0 + ai * HALF + m * 16; const size_t off = (size_t)row * 2048 + col0; float s = 0.f, r = 1.f;
                if (MODE == 1) { const f32x4 a = *(const f32x4*)(ssin + (size_t)row * 8), b = *(const f32x4*)(ssin + (size_t)row * 8 + 4);
                    r = rsqrtf((((a[0] + a[1]) + (a[2] + a[3])) + ((b[0] + b[1]) + (b[2] + b[3]))) * (1.f / 2048.f) + eps); }
#pragma unroll
                for (int bj = 0; bj < 2; ++bj)
#pragma unroll
                    for (int n = 0; n < 2; ++n) { const size_t o = off + bj * HALF + n * 16; f32x4 h = *(const f32x4*)(res + o); f32x4 a = acc[ai][bj][m][n];
                        if (MODE == 1) { const f32x4 t = *(const f32x4*)(tmp + o); for (int e = 0; e < 4; ++e) a[e] = sigmoid_f(a[e] * r) * t[e]; }
                        h = h + a; *(f32x4*)(out + o) = h;
                        if (hb) { u32x2 w; w.x = pk_bf16(h[0], h[1]); w.y = pk_bf16(h[2], h[3]); *(u32x2*)(hb + o) = w; }
                        s += (h[0] * h[0] + h[1] * h[1]) + (h[2] * h[2] + h[3] * h[3]);
                        if (MODE == 1) asm volatile("" ::: "memory"); }
                s += __shfl_xor(s, 16); s += __shfl_xor(s, 32);
                if (fq == 0) xlds[(ai * HALF + wr * 64 + m * 16 + fr) * 4 + wc] = s;
                if (MODE == 1) asm volatile("" ::: "memory"); }
        asm volatile("s_waitcnt lgkmcnt(0)" ::: "memory"); __builtin_amdgcn_s_barrier(); asm volatile("" ::: "memory");
        const int t = threadIdx.x;
        if (t < 256) { const f32x4 x = *(const PG8_LAS f32x4*)(xlds + t * 4); ss[(size_t)(u.pm * BM + t) * 8 + u.pn] = (x[0] + x[1]) + (x[2] + x[3]); }
    }
};
struct EpiGU {
    static constexpr bool PERM = true, AFTER_DRAIN = false;
    const float* ssin; bf16_t* act; float eps;
    __device__ __forceinline__ void operator()(const f32x4 (&acc)[2][2][4][2], const Unit& u, int wr, int wc, int fr, int fq) const {
        const int row0 = u.pm * BM + wr * 64 + fr, col0 = u.pn * HALF + wc * 32 + 8 * fq;
#pragma unroll
        for (int ai = 0; ai < 2; ++ai)
#pragma unroll
            for (int m = 0; m < 4; ++m) { const int row = row0 + ai * HALF + m * 16;
                const f32x4 a = *(const f32x4*)(ssin + (size_t)row * 8), b = *(const f32x4*)(ssin + (size_t)row * 8 + 4);
                const float r = rsqrtf((((a[0] + a[1]) + (a[2] + a[3])) + ((b[0] + b[1]) + (b[2] + b[3]))) * (1.f / 2048.f) + eps);
                const f32x4 g0 = acc[ai][0][m][0] * r, g1 = acc[ai][0][m][1] * r, u0 = acc[ai][1][m][0] * r, u1 = acc[ai][1][m][1] * r;
                u32x4 w; w.x = pk_bf16(silu_f(g0[0]) * u0[0], silu_f(g0[1]) * u0[1]); w.y = pk_bf16(silu_f(g0[2]) * u0[2], silu_f(g0[3]) * u0[3]);
                w.z = pk_bf16(silu_f(g1[0]) * u1[0], silu_f(g1[1]) * u1[1]); w.w = pk_bf16(silu_f(g1[2]) * u1[2], silu_f(g1[3]) * u1[3]);
                *(u32x4*)(act + (size_t)row * 5632 + col0) = w; }
    }
};
struct EpiF32 {
    static constexpr bool PERM = false, AFTER_DRAIN = false;
    float* C;
    __device__ __forceinline__ void operator()(const f32x4 (&acc)[2][2][4][2], const Unit& u, int wr, int wc, int fr, int fq) const {
        const int row0 = u.pm * BM + wr * 64 + fr, col0 = u.pn * BM + wc * 32 + 4 * fq;
#pragma unroll
        for (int ai = 0; ai < 2; ++ai)
#pragma unroll
            for (int m = 0; m < 4; ++m) { float* rowp = C + (size_t)(row0 + ai * HALF + m * 16) * 2048 + col0;
#pragma unroll
                for (int bj = 0; bj < 2; ++bj)
#pragma unroll
                    for (int n = 0; n < 2; ++n) *(f32x4*)(rowp + bj * HALF + n * 16) = acc[ai][bj][m][n]; }
    }
};
template <class Epi, class Sched, bool ALIGN_EPI = false, bool SP2 = false>
__device__ __forceinline__ void gemm_phase(PG8_LAS unsigned char* lds, const Gemm g, const Sched& S, const Epi& E) {
    const int tid = threadIdx.x, wid = __builtin_amdgcn_readfirstlane(tid >> 6), lane = tid & 63, wr = wid >> 2, wc = wid & 3, fr = lane & 15, fq = lane >> 4;
    const int K = g.K, nt = K / BK;
    unsigned voffA[2], voffB[2];
#pragma unroll
    for (int i = 0; i < 2; ++i) { int R, C; stage_rc(tid * 16 + i * 8192, R, C); const int Rb = Epi::PERM ? ((R & ~31) + perm32(R & 31)) : R;
        voffA[i] = (unsigned)(R * K + C) * 2u; voffB[i] = (unsigned)(Rb * K + C) * 2u; }
    const size_t kstep = (size_t)(BK * 2);
    const size_t hstep = (size_t)HALF * K * 2;
    const size_t tstep = 2 * hstep;
    const unsigned ldsw = (unsigned)wid * 1024u;
    const int aoff = lds_byte(wr * 64 + fr, fq * 8), boff = lds_byte(wc * 32 + fr, fq * 8);
#define PG8_SA(b, h) (((b) * 2 + (h)) * HTB)
#define PG8_SB(b, h) ((4 + (b) * 2 + (h)) * HTB)
#define PG8_STAGE(bufoff, gbase, voff) do { _Pragma("unroll") for (int _i = 0; _i < 2; ++_i) \
        __builtin_amdgcn_global_load_lds((const unsigned*)((const char*)(gbase) + (voff)[_i]), (PG8_LAS unsigned*)(lds + (bufoff) + ldsw + _i * 8192), 16, 0, 0); } while (0)
#define PG8_LDA(dst, b, h) do { _Pragma("unroll") for (int m = 0; m < 4; ++m) _Pragma("unroll") for (int k = 0; k < 2; ++k) dst[m][k] = *(const PG8_LAS bf16x8*)(lds + PG8_SA(b, h) + aoff + m * 2048 + k * 1024); } while (0)
#define PG8_LDB(dst, b, h) do { _Pragma("unroll") for (int n = 0; n < 2; ++n) _Pragma("unroll") for (int k = 0; k < 2; ++k) dst[n][k] = *(const PG8_LAS bf16x8*)(lds + PG8_SB(b, h) + boff + n * 2048 + k * 1024); } while (0)
#define PG8_MMA(ai, bj, At, Bt) do { __builtin_amdgcn_s_setprio(1); _Pragma("unroll") for (int m = 0; m < 4; ++m) _Pragma("unroll") for (int n = 0; n < 2; ++n) _Pragma("unroll") for (int k = 0; k < 2; ++k) \
        acc[ai][bj][m][n] = __builtin_amdgcn_mfma_f32_16x16x32_bf16(Bt[n][k], At[m][k], acc[ai][bj][m][n], 0, 0, 0); __builtin_amdgcn_s_setprio(0); } while (0)
#define PG8_WAIT_V(n) asm volatile("s_waitcnt vmcnt(" #n ")" ::: "memory")
#define PG8_WAIT_L(n) asm volatile("s_waitcnt lgkmcnt(" #n ")" ::: "memory")
#define PG8_BAR __builtin_amdgcn_s_barrier()
#define PG8_SCHED __builtin_amdgcn_sched_barrier(0)
    Unit cur, nxt; int ui = 0;
    if (!S.next(0, cur)) return;
    f32x4 acc[2][2][4][2];
#pragma unroll
    for (int a = 0; a < 2; ++a)
#pragma unroll
        for (int b = 0; b < 2; ++b)
#pragma unroll
            for (int m = 0; m < 4; ++m)
#pragma unroll
                for (int n = 0; n < 2; ++n) acc[a][b][m][n] = (f32x4){0.f, 0.f, 0.f, 0.f};
    bf16x8 At[4][2], B0[2][2], B1[2][2];
    const char* cA = (const char*)g.A + (size_t)cur.pm * tstep; const char* cB = (const char*)g.Bt + (size_t)cur.pn * tstep;
    S.a_ready(cur);
    if constexpr (SP2) {
        PG8_STAGE(PG8_SB(0, 0), cB, voffB); PG8_STAGE(PG8_SB(0, 1), cB + hstep, voffB); PG8_STAGE(PG8_SA(0, 0), cA, voffA); PG8_STAGE(PG8_SA(0, 1), cA + hstep, voffA);
        if (wr == 1) PG8_BAR;
        PG8_WAIT_V(2); PG8_BAR;
        PG8_STAGE(PG8_SB(1, 0), cB + kstep, voffB); PG8_STAGE(PG8_SA(1, 0), cA + kstep, voffA); PG8_STAGE(PG8_SB(1, 1), cB + hstep + kstep, voffB);
        PG8_WAIT_V(6); PG8_BAR;
    } else {
        PG8_STAGE(PG8_SB(0, 0), cB, voffB); PG8_STAGE(PG8_SA(0, 0), cA, voffA); PG8_STAGE(PG8_SB(0, 1), cB + hstep, voffB); PG8_STAGE(PG8_SA(0, 1), cA + hstep, voffA);
        if (wr == 1) PG8_BAR;
        PG8_WAIT_V(4); PG8_BAR;
        PG8_STAGE(PG8_SB(1, 0), cB + kstep, voffB); PG8_STAGE(PG8_SA(1, 0), cA + kstep, voffA); PG8_STAGE(PG8_SB(1, 1), cB + hstep + kstep, voffB);
        PG8_WAIT_V(6); PG8_BAR;
    }
    for (;;) {
        const bool has_next = S.next(ui + 1, nxt);
        const char* nA = has_next ? (const char*)g.A + (size_t)nxt.pm * tstep : cA; const char* nB = has_next ? (const char*)g.Bt + (size_t)nxt.pn * tstep : cB;
        for (int t = 0; t < nt; t += 2) {
            const bool last = (t == nt - 2);
            const char* a1 = cA + (size_t)(t + 1) * kstep;
            const char* a2 = last ? nA : cA + (size_t)(t + 2) * kstep; const char* b2 = last ? nB : cB + (size_t)(t + 2) * kstep;
            const char* a3 = a2 + kstep; const char* b3 = b2 + kstep;
            if (last && has_next) S.a_ready(nxt);
            if constexpr (SP2) {
            PG8_LDB(B0, 0, 0); PG8_LDB(B1, 0, 1); PG8_SCHED; PG8_LDA(At, 0, 0); PG8_STAGE(PG8_SA(1, 1), a1 + hstep, voffA);
            PG8_WAIT_V(8); PG8_WAIT_L(0); PG8_BAR; PG8_MMA(0, 0, At, B0); PG8_MMA(0, 1, At, B1); PG8_BAR; PG8_SCHED;
            PG8_LDA(At, 0, 1); PG8_STAGE(PG8_SB(0, 0), b2, voffB); PG8_STAGE(PG8_SB(0, 1), b2 + hstep, voffB); PG8_STAGE(PG8_SA(0, 0), a2, voffA);
            PG8_WAIT_V(8); PG8_WAIT_L(0); PG8_BAR; PG8_MMA(1, 0, At, B0); PG8_MMA(1, 1, At, B1); PG8_BAR; PG8_SCHED;
            PG8_LDB(B0, 1, 0); PG8_LDB(B1, 1, 1); PG8_SCHED; PG8_LDA(At, 1, 0); PG8_STAGE(PG8_SA(0, 1), a2 + hstep, voffA);
            PG8_WAIT_V(8); PG8_WAIT_L(0); PG8_BAR; PG8_MMA(0, 0, At, B0); PG8_MMA(0, 1, At, B1); PG8_BAR; PG8_SCHED;
            PG8_LDA(At, 1, 1); PG8_STAGE(PG8_SB(1, 0), b3, voffB); PG8_STAGE(PG8_SB(1, 1), b3 + hstep, voffB); PG8_STAGE(PG8_SA(1, 0), a3, voffA);
            PG8_WAIT_V(8); PG8_WAIT_L(0); PG8_BAR; PG8_MMA(1, 0, At, B0); PG8_MMA(1, 1, At, B1); PG8_BAR; PG8_SCHED;
            } else {
            PG8_LDB(B0, 0, 0); PG8_SCHED; PG8_LDA(At, 0, 0); PG8_STAGE(PG8_SA(1, 1), a1 + hstep, voffA);
            PG8_WAIT_L(8); PG8_BAR; PG8_WAIT_L(0); PG8_MMA(0, 0, At, B0); PG8_BAR; PG8_SCHED;
            PG8_LDB(B1, 0, 1); PG8_STAGE(PG8_SB(0, 0), b2, voffB);
            PG8_BAR; PG8_WAIT_L(0); PG8_MMA(0, 1, At, B1); PG8_BAR;
            PG8_LDA(At, 0, 1); PG8_STAGE(PG8_SA(0, 0), a2, voffA);
            PG8_BAR; PG8_WAIT_L(0); PG8_MMA(1, 0, At, B0); PG8_BAR; PG8_SCHED;
            PG8_STAGE(PG8_SB(0, 1), b2 + hstep, voffB);
            PG8_WAIT_V(6); PG8_BAR; PG8_MMA(1, 1, At, B1); PG8_BAR;
            PG8_LDB(B0, 1, 0); PG8_SCHED; PG8_LDA(At, 1, 0); PG8_STAGE(PG8_SA(0, 1), a2 + hstep, voffA);
            PG8_WAIT_L(8); PG8_BAR; PG8_WAIT_L(0); PG8_MMA(0, 0, At, B0); PG8_BAR; PG8_SCHED;
            PG8_LDB(B1, 1, 1); PG8_STAGE(PG8_SB(1, 0), b3, voffB);
            PG8_BAR; PG8_WAIT_L(0); PG8_MMA(0, 1, At, B1); PG8_BAR;
            PG8_LDA(At, 1, 1); PG8_STAGE(PG8_SA(1, 0), a3, voffA);
            PG8_BAR; PG8_WAIT_L(0); PG8_MMA(1, 0, At, B0); PG8_BAR; PG8_SCHED;
            PG8_STAGE(PG8_SB(1, 1), b3 + hstep, voffB);
            PG8_WAIT_V(6); PG8_BAR; PG8_MMA(1, 1, At, B1); PG8_BAR;
            }
        }
        if constexpr (ALIGN_EPI) { if (wr == 0) PG8_BAR; }
        if constexpr (!Epi::AFTER_DRAIN) { E(acc, cur, wr, wc, fr, fq); S.done(cur); }
        if (!has_next) break;
#pragma unroll
        for (int a = 0; a < 2; ++a)
#pragma unroll
            for (int b = 0; b < 2; ++b)
#pragma unroll
                for (int m = 0; m < 4; ++m)
#pragma unroll
                    for (int n = 0; n < 2; ++n) acc[a][b][m][n] = (f32x4){0.f, 0.f, 0.f, 0.f};
        cur = nxt; cA = nA; cB = nB; ++ui;
        if constexpr (ALIGN_EPI) { if (wr == 1) PG8_BAR; }
    }
    PG8_WAIT_V(0);
    if constexpr (!ALIGN_EPI) { if (wr == 0) PG8_BAR; }
    PG8_BAR;
    if constexpr (Epi::AFTER_DRAIN) { E.fused(acc, cur, wr, wc, fr, fq, lds, wid, lane); S.done(cur); }
#undef PG8_SA
#undef PG8_SB
#undef PG8_STAGE
#undef PG8_LDA
#undef PG8_LDB
#undef PG8_MMA
#undef PG8_WAIT_V
#undef PG8_WAIT_L
#undef PG8_BAR
#undef PG8_SCHED
}
}

#ifndef MK_N_LAUNCHES
#define MK_N_LAUNCHES 1
#endif
constexpr int NPHASE = 11;
constexpr int NWAVES = 8, NTHREADS = 512;
constexpr int BATCH = 4, SEQ = 2048, DM = 2048, M = BATCH * SEQ;
constexpr int QD = 1024, KVD = 256, DI = 2048, CONVD = 3072, NH = 32, FF = 5632, PLE = 256;
constexpr int NIN = 10784, NINP = 11008;
constexpr int NCH = SEQ / 128;
constexpr size_t MiB = 1u << 20;
constexpr size_t WS_CTL = 0, CTL_ZERO_BYTES = 65536;
constexpr size_t WS_CS = 1 * MiB;
constexpr size_t WS_SSQ = 3 * MiB, WS_SS1 = WS_SSQ + 256 * 1024, WS_SS2 = WS_SS1 + 256 * 1024, WS_SS3 = WS_SS2 + 256 * 1024;
constexpr size_t WS_ACS = 4 * MiB, WS_DT = 5 * MiB;
constexpr size_t WS_WIN = 6 * MiB, WS_U = 49 * MiB;
constexpr size_t WS_WATTN = 81 * MiB, WS_WSSD = 85 * MiB, WS_WO = 93 * MiB, WS_WGU = 101 * MiB, WS_WDOWN = 145 * MiB, WS_WPG = 167 * MiB, WS_WPP = 175 * MiB;
constexpr size_t WS_Q = 176 * MiB, WS_K = 192 * MiB, WS_V = 196 * MiB, WS_SZ = 200 * MiB, WS_XBC = 232 * MiB;
constexpr size_t WS_ATTN = 280 * MiB, WS_PREV = 296 * MiB, WS_PB = 328 * MiB, WS_END = 332 * MiB;
constexpr size_t WS_STATES = 6 * MiB;
constexpr size_t WS_YP = 6 * MiB;
constexpr size_t WS_TMP = 176 * MiB, WS_MERGED = 240 * MiB;
constexpr size_t WS_H1B = 6 * MiB, WS_ACT = 176 * MiB, WS_H2B = 38 * MiB;
static_assert(WS_WIN + (size_t)NINP * DM * 2 <= WS_U && WS_U + (size_t)M * DM * 2 <= WS_WATTN && WS_WPP + (size_t)DM * PLE * 2 <= WS_Q, "ws map 1");
static_assert(WS_XBC + (size_t)M * CONVD * 2 <= WS_ATTN && WS_PB + (size_t)M * PLE * 2 <= WS_END && WS_STATES + (size_t)M / 128 * NH * 8192 * 4 <= WS_WATTN, "ws map 2");
static_assert(WS_ACT + (size_t)M * FF * 2 <= WS_ATTN && WS_MERGED + (size_t)M * DM * 2 <= WS_ATTN && WS_WGU + (size_t)2 * FF * DM * 2 <= WS_WDOWN && WS_WDOWN + (size_t)DM * FF * 2 <= WS_WPG, "ws map 3");
constexpr int CW_BAR = 4096;
constexpr int RING_BYTES = 131072, XLDS_OFF = RING_BYTES, LDS_BYTES = 147456, MISC_OFF = LDS_BYTES - 256;

#define GAS __attribute__((address_space(1)))
#define LAS __attribute__((address_space(3)))
typedef unsigned short bf16;
typedef unsigned v4u __attribute__((ext_vector_type(4)));
typedef unsigned v2u __attribute__((ext_vector_type(2)));
typedef float f32x4 __attribute__((ext_vector_type(4)));
typedef float f32x16 __attribute__((ext_vector_type(16)));
typedef float f32x2p __attribute__((ext_vector_type(2)));
typedef short bf16x8 __attribute__((ext_vector_type(8)));
#define LDS_WAIT() asm volatile("s_waitcnt lgkmcnt(0)" ::: "memory")
#define VM_WAIT() asm volatile("s_waitcnt vmcnt(0)" ::: "memory")
using pg8::pk_bf16; using pg8::bf_lo; using pg8::bf_hi; using pg8::silu_f; using pg8::sigmoid_f;
__device__ __forceinline__ float bf2f(bf16 x) { return __uint_as_float((unsigned)x << 16); }
constexpr float LOG2E = 1.4426950408889634f;

#define XB_TMO      128
#define XB_XCNT(j)  (256  + 64 * (j))
#define XB_XSUB(j)  (1280 + 64 * (j))
#define XB_XGEN(j)  (2304 + 64 * (j))
#define XB_TOP      3328
#define XB_TOPGEN   3392
#define XCD_BAR_WORDS 3456
#define XB_SPIN_CAP (1u << 18)
__device__ __forceinline__ unsigned xb_ld(unsigned* p)              { return __hip_atomic_load(p, __ATOMIC_RELAXED, __HIP_MEMORY_SCOPE_AGENT); }
__device__ __forceinline__ unsigned xb_add(unsigned* p, unsigned v) { return __hip_atomic_fetch_add(p, v, __ATOMIC_RELAXED, __HIP_MEMORY_SCOPE_AGENT); }
__device__ __forceinline__ unsigned xb_xcc_id() { return (unsigned)__builtin_amdgcn_s_getreg((3 << 11) | 20) & 0xFu; }
#define XB_SPIN(cond, bar) do { unsigned _sp = 0; while (cond) { __builtin_amdgcn_s_sleep(1); \
    if ((++_sp & 255u) == 0u) { if (xb_ld(&(bar)[XB_TMO])) break; if (_sp > XB_SPIN_CAP) { atomicAdd(&(bar)[XB_TMO], 1u); break; } } } } while (0)
struct XcdBarrier { unsigned* bar; unsigned x; volatile LAS unsigned* st; };
__device__ __forceinline__ XcdBarrier xcd_barrier_post(unsigned* bar, volatile LAS unsigned* st) {
    XcdBarrier b; b.bar = bar; b.x = xb_xcc_id(); b.st = st;
    if (threadIdx.x == 0) (void)xb_add(&bar[XB_XCNT(b.x)], 1u);
    return b;
}
__device__ __forceinline__ void xcd_barrier_complete(unsigned* bar, unsigned x, unsigned& nloc, unsigned& nx) {
    const unsigned G = gridDim.x * gridDim.y * gridDim.z;
    unsigned sum, cnt, mine, sp = 0u;
    for (;;) {
        sum = 0u; cnt = 0u; mine = 0u;
#pragma unroll
        for (unsigned j = 0; j < 16; ++j) { const unsigned c = xb_ld(&bar[XB_XCNT(j)]); sum += c; cnt += (c > 0u) ? 1u : 0u; mine = (j == x) ? c : mine; }
        if (sum == G) break;
        __builtin_amdgcn_s_sleep(1);
        if ((++sp & 255u) == 0u) { if (xb_ld(&bar[XB_TMO])) break; if (sp > XB_SPIN_CAP) { atomicAdd(&bar[XB_TMO], 1u); break; } }
    }
    nloc = mine > 0u ? mine : 1u; nx = cnt > 0u ? cnt : 1u;
}
__device__ __forceinline__ void xcd_barrier(const XcdBarrier& b) {
    asm volatile("s_waitcnt vmcnt(0)" ::: "memory");
    __syncthreads();
    if (threadIdx.x == 0) {
        unsigned* bar = b.bar;
        __builtin_amdgcn_s_waitcnt(0);
        unsigned nloc = b.st[0], nx = b.st[1];
        if (nloc == 0u) { xcd_barrier_complete(bar, b.x, nloc, nx); b.st[0] = nloc; b.st[1] = nx; }
        const unsigned old = xb_add(&bar[XB_XSUB(b.x)], 1u);
        const unsigned gen = old / nloc;
        if (old + 1u == (gen + 1u) * nloc) {
            __builtin_amdgcn_fence(__ATOMIC_RELEASE, "agent");
            asm volatile("s_waitcnt vmcnt(0)" ::: "memory");
            const unsigned og = xb_add(&bar[XB_TOP], 1u);
            const unsigned tg = og / nx;
            if (og + 1u == (tg + 1u) * nx) xb_add(&bar[XB_TOPGEN], 1u);
            else XB_SPIN(xb_ld(&bar[XB_TOPGEN]) == tg, bar);
            __builtin_amdgcn_fence(__ATOMIC_ACQUIRE, "agent");
            xb_add(&bar[XB_XGEN(b.x)], 1u);
            asm volatile("s_waitcnt vmcnt(0)" ::: "memory");
        } else {
            XB_SPIN(xb_ld(&bar[XB_XGEN(b.x)]) == gen, bar);
            __builtin_amdgcn_fence(__ATOMIC_ACQUIRE, "agent");
            asm volatile("s_waitcnt vmcnt(0)" ::: "memory");
        }
    }
    __syncthreads();
}

enum { I_X = 0, I_P, I_POS, I_GMIX, I_WIN, I_CONVW, I_CONVB, I_DTB, I_ALOG, I_DSKIP, I_GSSD, I_SINKS, I_WATTN, I_WSSD, I_WO, I_GFFN, I_WGATE, I_WUP, I_WDOWN, I_GPLE, I_WPG, I_WPP, I_GFIN, N_IN };
struct Args { const void* in[N_IN]; float* out; unsigned char* ws; int ph_lo, ph_hi; };

__device__ __forceinline__ float wave_sum(float v) {
#pragma unroll
    for (int o = 1; o < 64; o <<= 1) v += __shfl_xor(v, o);
    return v;
}

__device__ __forceinline__ int phys_row(int kind, int n) {
    if (kind == 0) return n;
    if (kind == 1) {
        if (n < 1280) { const int d = n & 63; return (n & ~63) + 2 * (d & 31) + (d >> 5); }
        if (n < 6656) return n;
        if (n < 6688) return 10752 + (n - 6656);
        return n - 32;
    }
    if (kind == 2) return ((n >> 7) << 8) + (n & 127);
    return ((n >> 7) << 8) + 128 + (n & 127);
}
__device__ __forceinline__ void p0_item(const float* W, int K, int N, bf16* WT, const float* g, int kind, LAS float* scr, int item, int lane) {
    const int nblk = N / 32, kb = item / nblk, nb = item % nblk, k0 = 64 * kb, n0 = 32 * nb;
#pragma unroll 8
    for (int i = 0; i < 32; ++i) { const int kk = 2 * i + (lane >> 5); float v = W[(size_t)(k0 + kk) * N + n0 + (lane & 31)]; if (g) v *= g[k0 + kk]; scr[kk * 33 + (lane & 31)] = v; }
    LDS_WAIT(); asm volatile("" ::: "memory");
    const int c = lane & 7;
#pragma unroll
    for (int j = 0; j < 4; ++j) { const int n = (lane >> 3) + 8 * j; const LAS float* s = scr + (8 * c) * 33 + n;
        v4u o; o.x = pk_bf16(s[0 * 33], s[1 * 33]); o.y = pk_bf16(s[2 * 33], s[3 * 33]); o.z = pk_bf16(s[4 * 33], s[5 * 33]); o.w = pk_bf16(s[6 * 33], s[7 * 33]);
        *(GAS v4u*)(WT + (size_t)phys_row(kind, n0 + n) * K + k0 + 8 * c) = o; }
    LDS_WAIT(); asm volatile("" ::: "memory");
}
__device__ __forceinline__ void p0_prologue(const Args& a, LAS unsigned char* lds, int vcu, int G) {
    const int tid = threadIdx.x, lane = tid & 63, wave = __builtin_amdgcn_readfirstlane(tid >> 6);
    unsigned char* ws = a.ws;
    LAS float* scr = (LAS float*)(lds + wave * 16384);
    const int gw = vcu * NWAVES + wave, NGW = G * NWAVES;
    constexpr int I0 = 32 * (NIN / 32), I1 = 16 * 64, I2 = 32 * 64, I3 = 32 * 64, I4 = 32 * (FF / 32), I5 = I4, I6 = (FF / 64) * 64, I7 = 32 * 64, I8 = 4 * 64;
    constexpr int NITEMS = I0 + I1 + I2 + I3 + I4 + I5 + I6 + I7 + I8;
    for (int it = gw; it < NITEMS; it += NGW) {
        int r = it;
        if (r < I0) { p0_item((const float*)a.in[I_WIN], DM, NIN, (bf16*)(ws + WS_WIN), (const float*)a.in[I_GMIX], 1, scr, r, lane); continue; } r -= I0;
        if (r < I1) { p0_item((const float*)a.in[I_WATTN], QD, DM, (bf16*)(ws + WS_WATTN), nullptr, 0, scr, r, lane); continue; } r -= I1;
        if (r < I2) { p0_item((const float*)a.in[I_WSSD], DI, DM, (bf16*)(ws + WS_WSSD), (const float*)a.in[I_GSSD], 0, scr, r, lane); continue; } r -= I2;
        if (r < I3) { p0_item((const float*)a.in[I_WO], DM, DM, (bf16*)(ws + WS_WO), nullptr, 0, scr, r, lane); continue; } r -= I3;
        if (r < I4) { p0_item((const float*)a.in[I_WGATE], DM, FF, (bf16*)(ws + WS_WGU), (const float*)a.in[I_GFFN], 2, scr, r, lane); continue; } r -= I4;
        if (r < I5) { p0_item((const float*)a.in[I_WUP], DM, FF, (bf16*)(ws + WS_WGU), (const float*)a.in[I_GFFN], 3, scr, r, lane); continue; } r -= I5;
        if (r < I6) { p0_item((const float*)a.in[I_WDOWN], FF, DM, (bf16*)(ws + WS_WDOWN), nullptr, 0, scr, r, lane); continue; } r -= I6;
        if (r < I7) { p0_item((const float*)a.in[I_WPG], DM, DM, (bf16*)(ws + WS_WPG), (const float*)a.in[I_GPLE], 0, scr, r, lane); continue; } r -= I7;
        p0_item((const float*)a.in[I_WPP], PLE, DM, (bf16*)(ws + WS_WPP), nullptr, 0, scr, r, lane);
    }
    const int gt = vcu * NTHREADS + tid, NGT = G * NTHREADS;
    { GAS v4u* z = (GAS v4u*)(ws + WS_WIN + (size_t)NIN * DM * 2); const int nz = (NINP - NIN) * DM * 2 / 16;
      for (int i = gt; i < nz; i += NGT) z[i] = (v4u){0u, 0u, 0u, 0u}; }
    { const float* x = (const float*)a.in[I_X]; bf16* U = (bf16*)(ws + WS_U);
      for (int m = gw; m < M; m += NGW) {
          const GAS f32x4* xr = (const GAS f32x4*)(x + (size_t)m * DM) + lane; f32x4 v[8]; float s = 0.f;
#pragma unroll
          for (int j = 0; j < 8; ++j) { v[j] = xr[64 * j]; s += (v[j][0] * v[j][0] + v[j][1] * v[j][1]) + (v[j][2] * v[j][2] + v[j][3] * v[j][3]); }
          const float r = rsqrtf(wave_sum(s) * (1.f / DM) + 1e-6f);
          GAS v2u* o = (GAS v2u*)(U + (size_t)m * DM) + lane;
#pragma unroll
          for (int j = 0; j < 8; ++j) { v2u w; w.x = pk_bf16(v[j][0] * r, v[j][1] * r); w.y = pk_bf16(v[j][2] * r, v[j][3] * r); o[64 * j] = w; } } }
    { const GAS f32x4* p = (const GAS f32x4*)a.in[I_P]; GAS v4u* o = (GAS v4u*)(ws + WS_PB); const int n8 = M * PLE / 8;
      for (int i = gt; i < n8; i += NGT) { const f32x4 v0 = p[2 * i], v1 = p[2 * i + 1]; v4u w; w.x = pk_bf16(v0[0], v0[1]); w.y = pk_bf16(v0[2], v0[3]); w.z = pk_bf16(v1[0], v1[1]); w.w = pk_bf16(v1[2], v1[3]); o[i] = w; } }
    { const int* pos = (const int*)a.in[I_POS]; float* cs = (float*)(ws + WS_CS);
      for (int i = gt; i < M * 32; i += NGT) { const int tok = i >> 5, fi = i & 31; const float inv = exp2f(-(float)fi * (13.287712379549449f / 32.f));
          const float ang = (float)pos[tok] * inv; float sn, cn; sincosf(ang, &sn, &cn); *(f32x2p*)(cs + 2 * (size_t)i) = (f32x2p){cn, sn}; } }
}

constexpr int KS_PITCH = 72, VT_PITCH = 264;
__device__ __forceinline__ void attn_unit(const Args& a, LAS unsigned char* lds, int unit) {
    const int tid = threadIdx.x, lane = tid & 63, wid = __builtin_amdgcn_readfirstlane(tid >> 6), r32 = lane & 31, hi = lane >> 5;
    const int hk = unit & 3, nb = (unit >> 2) & 15, b = unit >> 6;
    const bf16* Q = (const bf16*)(a.ws + WS_Q); const bf16* K = (const bf16*)(a.ws + WS_K); const bf16* V = (const bf16*)(a.ws + WS_V); bf16* O = (bf16*)(a.ws + WS_ATTN);
    const int tok0 = b * SEQ + nb * 128 - 128;
    LAS bf16* Ks = (LAS bf16*)lds; LAS bf16* VT = (LAS bf16*)(lds + 256 * KS_PITCH * 2);
    {
        const int row = tid >> 1, half = tid & 1; const bool valid = (nb > 0) || (row >= 128);
        v4u kv[4], vv[4];
        if (valid) { const GAS v4u* kp = (const GAS v4u*)(K + (size_t)(tok0 + row) * KVD + hk * 64 + half * 32); const GAS v4u* vp = (const GAS v4u*)(V + (size_t)(tok0 + row) * KVD + hk * 64 + half * 32);
#pragma unroll
            for (int i = 0; i < 4; ++i) { kv[i] = kp[i]; vv[i] = vp[i]; } }
        else {
#pragma unroll
            for (int i = 0; i < 4; ++i) { kv[i] = (v4u){0u, 0u, 0u, 0u}; vv[i] = (v4u){0u, 0u, 0u, 0u}; } }
#pragma unroll
        for (int i = 0; i < 4; ++i) *(LAS v4u*)(Ks + row * KS_PITCH + half * 32 + i * 8) = kv[i];
        const int pos = (row & ~12) | ((row & 4) << 1) | ((row & 8) >> 1);
#pragma unroll
        for (int i = 0; i < 4; ++i)
#pragma unroll
            for (int e = 0; e < 4; ++e) { const unsigned w = vv[i][e]; const int d = half * 32 + 8 * i + 2 * e;
                VT[d * VT_PITCH + pos] = (bf16)(w & 0xffffu); VT[(d + 1) * VT_PITCH + pos] = (bf16)(w >> 16); }
    }
    __syncthreads();
    const int head = hk * 4 + (wid >> 1);
    const float sink2 = ((const float*)a.in[I_SINKS])[head] * LOG2E;
#pragma unroll 1
    for (int qq = 0; qq < 2; ++qq) {
        const int qb = 2 * (wid & 1) + qq, q0 = 32 * qb, qi = q0 + r32;
        const size_t tokq = (size_t)(b * SEQ + nb * 128 + qi);
        bf16x8 qf[4];
#pragma unroll
        for (int ks = 0; ks < 4; ++ks) qf[ks] = *(const GAS bf16x8*)(Q + tokq * QD + head * 64 + 16 * ks + 8 * hi);
        f32x16 S[5];
#pragma unroll
        for (int t = 0; t < 5; ++t) { S[t] = (f32x16){};
#pragma unroll
            for (int ks = 0; ks < 4; ++ks) { const bf16x8 kf = *(const LAS bf16x8*)(Ks + (32 * (qb + t) + r32) * KS_PITCH + 16 * ks + 8 * hi);
                S[t] = __builtin_amdgcn_mfma_f32_32x32x16_bf16(kf, qf[ks], S[t], 0, 0, 0); } }
        float mx = sink2;
#pragma unroll
        for (int t = 0; t < 5; ++t)
#pragma unroll
            for (int r = 0; r < 16; ++r) { const int j = 32 * (qb + t) + (r & 3) + 8 * (r >> 2) + 4 * hi;
                const bool ok = (j > qi) && (j <= qi + 128) && ((nb > 0) || (j >= 128));
                S[t][r] = ok ? S[t][r] : -INFINITY; mx = fmaxf(mx, S[t][r]); }
        mx = fmaxf(mx, __shfl_xor(mx, 32));
        float sum = 0.f;
#pragma unroll
        for (int t = 0; t < 5; ++t)
#pragma unroll
            for (int r = 0; r < 16; ++r) { const float p = __builtin_amdgcn_exp2f(S[t][r] - mx); S[t][r] = p; sum += p; }
        sum += __shfl_xor(sum, 32); sum += __builtin_amdgcn_exp2f(sink2 - mx);
        const float inv = 1.f / sum;
        f32x16 Oa[2]; Oa[0] = (f32x16){}; Oa[1] = (f32x16){};
#pragma unroll
        for (int t = 0; t < 5; ++t)
#pragma unroll
            for (int s2 = 0; s2 < 2; ++s2) { bf16x8 pf; { v4u w; w.x = pk_bf16(S[t][8 * s2 + 0], S[t][8 * s2 + 1]); w.y = pk_bf16(S[t][8 * s2 + 2], S[t][8 * s2 + 3]); w.z = pk_bf16(S[t][8 * s2 + 4], S[t][8 * s2 + 5]); w.w = pk_bf16(S[t][8 * s2 + 6], S[t][8 * s2 + 7]); pf = __builtin_bit_cast(bf16x8, w); }
#pragma unroll
                for (int db = 0; db < 2; ++db) { const bf16x8 vf = *(const LAS bf16x8*)(VT + (32 * db + r32) * VT_PITCH + 32 * (qb + t) + 16 * s2 + 8 * hi);
                    Oa[db] = __builtin_amdgcn_mfma_f32_32x32x16_bf16(vf, pf, Oa[db], 0, 0, 0); } }
#pragma unroll
        for (int db = 0; db < 2; ++db)
#pragma unroll
            for (int rq = 0; rq < 4; ++rq) { v2u w; w.x = pk_bf16(Oa[db][4 * rq] * inv, Oa[db][4 * rq + 1] * inv); w.y = pk_bf16(Oa[db][4 * rq + 2] * inv, Oa[db][4 * rq + 3] * inv);
                *(GAS v2u*)(O + tokq * QD + head * 64 + 32 * db + 8 * rq + 4 * hi) = w; }
    }
    __syncthreads();
}

constexpr int BC_PITCH = 136;
template <bool S1> __device__ __forceinline__ void conv_bc(const Args& a, int t0, bool first, int g, LAS bf16* Bimg, LAS bf16* Cimg) {
    const int tid = threadIdx.x, cp = tid & 127, tq = tid >> 7;
    if (S1 && cp >= 64) return;
    const bf16* xbc = (const bf16*)(a.ws + WS_XBC); const float* cw = (const float*)a.in[I_CONVW]; const float* cb = (const float*)a.in[I_CONVB];
    const int chan = (cp < 64) ? (2048 + 128 * g + 2 * cp) : (2560 + 128 * g + 2 * (cp - 64));
    float w[4][2], bias[2];
#pragma unroll
    for (int k = 0; k < 4; ++k) { w[k][0] = cw[k * CONVD + chan]; w[k][1] = cw[k * CONVD + chan + 1]; }
    bias[0] = cb[chan]; bias[1] = cb[chan + 1];
    const int l0 = 32 * tq;
    unsigned xin[35];
#pragma unroll
    for (int i = 0; i < 35; ++i) { const int l = l0 - 3 + i; xin[i] = (first && l < 0) ? 0u : *(const GAS unsigned*)(xbc + (size_t)(t0 + l) * CONVD + chan); }
#pragma unroll
    for (int l = 0; l < 32; ++l) {
        float o0 = bias[0], o1 = bias[1];
#pragma unroll
        for (int k = 0; k < 4; ++k) { o0 += w[k][0] * bf_lo(xin[l + k]); o1 += w[k][1] * bf_hi(xin[l + k]); }
        o0 = silu_f(o0); o1 = silu_f(o1);
        if (S1) { const unsigned pk = pk_bf16(o0, o1); Bimg[(2 * cp) * BC_PITCH + l0 + l] = (bf16)(pk & 0xffffu); Bimg[(2 * cp + 1) * BC_PITCH + l0 + l] = (bf16)(pk >> 16); }
        else { LAS bf16* img = (cp < 64) ? Bimg : Cimg; *(LAS unsigned*)(img + (l0 + l) * BC_PITCH + 2 * (cp & 63)) = pk_bf16(o0, o1); }
    }
}
template <int NT> __device__ __forceinline__ void conv_x(const bf16* xcol  , int l, bool first, const float (&w)[4], float bias, float (&out)[NT]) {
    float xin[NT + 3];
#pragma unroll
    for (int i = 0; i < NT + 3; ++i) { const int ll = l - 3 + i; xin[i] = (first && ll < 0) ? 0.f : bf2f(*(const GAS bf16*)(xcol + (ptrdiff_t)ll * CONVD)); }
#pragma unroll
    for (int j = 0; j < NT; ++j) out[j] = silu_f(bias + w[0] * xin[j] + w[1] * xin[j + 1] + w[2] * xin[j + 2] + w[3] * xin[j + 3]);
}

__device__ __forceinline__ void ssd_states_unit(const Args& a, LAS unsigned char* lds, int unit) {
    const int tid = threadIdx.x, lane = tid & 63, wid = __builtin_amdgcn_readfirstlane(tid >> 6), r32 = lane & 31, hi = lane >> 5;
    const int g = unit & 3, c = (unit >> 2) & 15, b = unit >> 6, t0 = b * SEQ + c * 128; const bool first = (c == 0);
    LAS bf16* BT = (LAS bf16*)lds; LAS float* wv = (LAS float*)(lds + 128 * BC_PITCH * 2) + wid * 128;
    conv_bc<true>(a, t0, first, g, BT, nullptr);
    const int hh = 8 * g + wid;
    const float* dtp = (const float*)(a.ws + WS_DT); float* acsg = (float*)(a.ws + WS_ACS);
    const float aneg = -expf(((const float*)a.in[I_ALOG])[hh]);
    {
        const float d0 = dtp[(size_t)(t0 + lane) * NH + hh], d1 = dtp[(size_t)(t0 + 64 + lane) * NH + hh];
        float c0 = d0 * aneg, c1 = d1 * aneg;
#pragma unroll
        for (int o = 1; o < 64; o <<= 1) { const float u0 = __shfl_up(c0, o), u1 = __shfl_up(c1, o); if (lane >= o) { c0 += u0; c1 += u1; } }
        c1 += __shfl(c0, 63); const float tot = __shfl(c1, 63);
        acsg[(size_t)(t0 + lane) * NH + hh] = c0; acsg[(size_t)(t0 + 64 + lane) * NH + hh] = c1;
        wv[lane] = d0 * expf(tot - c0); wv[lane + 64] = d1 * expf(tot - c1);
    }
    __syncthreads();
    const bf16* xbc = (const bf16*)(a.ws + WS_XBC); const float* cw = (const float*)a.in[I_CONVW]; const float* cb = (const float*)a.in[I_CONVB];
    float* st = (float*)(a.ws + WS_STATES) + (size_t)((b * NCH + c) * NH + hh) * 8192;
#pragma unroll 1
    for (int pb = 0; pb < 2; ++pb) {
        const int ch = hh * 64 + 32 * pb + r32;
        float w[4]; for (int k = 0; k < 4; ++k) w[k] = cw[k * CONVD + ch]; const float bias = cb[ch];
        const bf16* xcol = xbc + (size_t)t0 * CONVD + ch;
        f32x16 acc[4]; for (int i = 0; i < 4; ++i) acc[i] = (f32x16){};
#pragma unroll 2
        for (int ks = 0; ks < 8; ++ks) {
            const int lb = 16 * ks + 8 * hi; float xv[8]; conv_x<8>(xcol, lb, first, w, bias, xv);
            const f32x4 w0 = *(const LAS f32x4*)(wv + lb), w1 = *(const LAS f32x4*)(wv + lb + 4);
            v4u pw; pw.x = pk_bf16(xv[0] * w0[0], xv[1] * w0[1]); pw.y = pk_bf16(xv[2] * w0[2], xv[3] * w0[3]); pw.z = pk_bf16(xv[4] * w1[0], xv[5] * w1[1]); pw.w = pk_bf16(xv[6] * w1[2], xv[7] * w1[3]);
            const bf16x8 bfr = __builtin_bit_cast(bf16x8, pw);
#pragma unroll
            for (int nb = 0; nb < 4; ++nb) { const bf16x8 af = *(const LAS bf16x8*)(BT + (32 * nb + r32) * BC_PITCH + lb); acc[nb] = __builtin_amdgcn_mfma_f32_32x32x16_bf16(af, bfr, acc[nb], 0, 0, 0); }
        }
#pragma unroll
        for (int nb = 0; nb < 4; ++nb)
#pragma unroll
            for (int rq = 0; rq < 4; ++rq) *(GAS f32x4*)(st + (size_t)(32 * pb + r32) * 128 + 32 * nb + 8 * rq + 4 * hi) = (f32x4){acc[nb][4 * rq], acc[nb][4 * rq + 1], acc[nb][4 * rq + 2], acc[nb][4 * rq + 3]};
    }
    __syncthreads();
}

__device__ __forceinline__ void ssd_scan(const Args& a, int vcu, int G) {
    const float* st = (const float*)(a.ws + WS_STATES); bf16* prev = (bf16*)(a.ws + WS_PREV); const float* acsg = (const float*)(a.ws + WS_ACS);
    const int gt = vcu * NTHREADS + threadIdx.x, NGT = G * NTHREADS;
    for (int i = gt; i < BATCH * NH * 2048; i += NGT) {
        const int e4 = i & 2047, hh = (i >> 11) & 31, b = i >> 16;
        f32x4 carry = (f32x4){0.f, 0.f, 0.f, 0.f};
#pragma unroll 4
        for (int c = 0; c < NCH; ++c) { const size_t off = (size_t)((b * NCH + c) * NH + hh) * 8192 + 4 * e4;
            const f32x4 s = *(const GAS f32x4*)(st + off); const float dec = expf(acsg[(size_t)(b * SEQ + c * 128 + 127) * NH + hh]);
            v2u w; w.x = pk_bf16(carry[0], carry[1]); w.y = pk_bf16(carry[2], carry[3]); *(GAS v2u*)(prev + off) = w;
            carry = carry * dec + s; }
    }
}

constexpr int S3_XF = 2 * 128 * BC_PITCH * 2, S3_TAB = S3_XF + 4 * 16384, S3_SSQ = S3_TAB + 4 * 1024, S3_END = S3_SSQ + 4 * 128 * 4;
__device__ __forceinline__ void ssd_out_unit(const Args& a, LAS unsigned char* lds, int unit) {
    const int tid = threadIdx.x, lane = tid & 63, wid = __builtin_amdgcn_readfirstlane(tid >> 6), r32 = lane & 31, hi = lane >> 5;
    const int hhalf = unit & 1, g = (unit >> 1) & 3, c = (unit >> 3) & 15, b = unit >> 7, t0 = b * SEQ + c * 128; const bool first = (c == 0);
    const int hl = wid >> 1, role = wid & 1, hh = 8 * g + 4 * hhalf + hl;
    LAS bf16* Bs = (LAS bf16*)lds; LAS bf16* Cs = Bs + 128 * BC_PITCH;
    LAS unsigned char* XF = lds + S3_XF + hl * 16384;
    LAS float* acsw = (LAS float*)(lds + S3_TAB) + hl * 256; LAS float* dtw = acsw + 128;
    LAS float* ssqx = (LAS float*)(lds + S3_SSQ);
    conv_bc<false>(a, t0, first, g, Bs, Cs);
    { const float* dtp = (const float*)(a.ws + WS_DT); const float* acsg = (const float*)(a.ws + WS_ACS); const int l = lane + 64 * role;
      acsw[l] = acsg[(size_t)(t0 + l) * NH + hh]; dtw[l] = dtp[(size_t)(t0 + l) * NH + hh]; }
    {
        const bf16* xbc = (const bf16*)(a.ws + WS_XBC); const float* cw = (const float*)a.in[I_CONVW]; const float* cb = (const float*)a.in[I_CONVB];
        const int ch = hh * 64 + 32 * role + r32;
        float w[4]; for (int k = 0; k < 4; ++k) w[k] = cw[k * CONVD + ch]; const float bias = cb[ch];
        const bf16* xcol = xbc + (size_t)t0 * CONVD + ch;
#pragma unroll
        for (int sb = 0; sb < 4; ++sb) {
#pragma unroll
            for (int s2 = 0; s2 < 2; ++s2) { const int l = 32 * sb + 16 * s2 + 4 * hi; float x0[4], x1[4]; conv_x<4>(xcol, l, first, w, bias, x0); conv_x<4>(xcol, l + 8, false, w, bias, x1);
                v4u pw; pw.x = pk_bf16(x0[0], x0[1]); pw.y = pk_bf16(x0[2], x0[3]); pw.z = pk_bf16(x1[0], x1[1]); pw.w = pk_bf16(x1[2], x1[3]);
                *(LAS v4u*)(XF + ((role * 4 + sb) * 2 + s2) * 1024 + lane * 16) = pw; }
            if (sb & 1) asm volatile("" ::: "memory"); }
    }
    __syncthreads();
    const float Dh = ((const float*)a.in[I_DSKIP])[hh];
    const bf16* prev = (const bf16*)(a.ws + WS_PREV) + (size_t)((b * NCH + c) * NH + hh) * 8192;
    const bf16* sz = (const bf16*)(a.ws + WS_SZ); bf16* yp = (bf16*)(a.ws + WS_YP);
#pragma unroll 1
    for (int it = 0; it < 2; ++it) {
        const int lb = role ? 1 + it : 3 * it;
        const int l = 32 * lb + r32; const float acs_l = acsw[l];
        bf16x8 Cf[8];
#pragma unroll
        for (int ks = 0; ks < 8; ++ks) Cf[ks] = *(const LAS bf16x8*)(Cs + l * BC_PITCH + 16 * ks + 8 * hi);
        f32x16 Y[2]; Y[0] = (f32x16){}; Y[1] = (f32x16){};
        if (!first) {
#pragma unroll
            for (int ks = 0; ks < 8; ++ks)
#pragma unroll
                for (int pb = 0; pb < 2; ++pb) { const bf16x8 pf = *(const GAS bf16x8*)(prev + (size_t)(32 * pb + r32) * 128 + 16 * ks + 8 * hi); Y[pb] = __builtin_amdgcn_mfma_f32_32x32x16_bf16(pf, Cf[ks], Y[pb], 0, 0, 0); }
            const float el = __builtin_amdgcn_exp2f(acs_l * LOG2E);
            Y[0] = Y[0] * el; Y[1] = Y[1] * el;
        }
#pragma unroll 1
        for (int sb = 0; sb <= lb; ++sb) {
            f32x16 cbt = (f32x16){};
#pragma unroll
            for (int ks = 0; ks < 8; ++ks) { const bf16x8 bfr = *(const LAS bf16x8*)(Bs + (32 * sb + r32) * BC_PITCH + 16 * ks + 8 * hi); cbt = __builtin_amdgcn_mfma_f32_32x32x16_bf16(bfr, Cf[ks], cbt, 0, 0, 0); }
            float gv[16];
#pragma unroll
            for (int rq = 0; rq < 4; ++rq) { const int s0 = 32 * sb + 8 * rq + 4 * hi; const f32x4 as = *(const LAS f32x4*)(acsw + s0), ds = *(const LAS f32x4*)(dtw + s0);
#pragma unroll
                for (int e = 0; e < 4; ++e) { float v = cbt[4 * rq + e] * ds[e] * __builtin_amdgcn_exp2f((acs_l - as[e]) * LOG2E);
                    const int s = s0 + e; v = (s > l) ? 0.f : v; v = (s == l) ? v + Dh : v;
                    gv[4 * rq + e] = v; } }
#pragma unroll
            for (int s2 = 0; s2 < 2; ++s2) { v4u pw; pw.x = pk_bf16(gv[8 * s2 + 0], gv[8 * s2 + 1]); pw.y = pk_bf16(gv[8 * s2 + 2], gv[8 * s2 + 3]); pw.z = pk_bf16(gv[8 * s2 + 4], gv[8 * s2 + 5]); pw.w = pk_bf16(gv[8 * s2 + 6], gv[8 * s2 + 7]);
                const bf16x8 gf = __builtin_bit_cast(bf16x8, pw);
                const bf16x8 x0 = *(const LAS bf16x8*)(XF + ((0 * 4 + sb) * 2 + s2) * 1024 + lane * 16), x1 = *(const LAS bf16x8*)(XF + ((1 * 4 + sb) * 2 + s2) * 1024 + lane * 16);
                Y[0] = __builtin_amdgcn_mfma_f32_32x32x16_bf16(x0, gf, Y[0], 0, 0, 0); Y[1] = __builtin_amdgcn_mfma_f32_32x32x16_bf16(x1, gf, Y[1], 0, 0, 0); }
        }
        const size_t tok = (size_t)(t0 + l); float ssq = 0.f;
#pragma unroll
        for (int pb = 0; pb < 2; ++pb)
#pragma unroll
            for (int rq = 0; rq < 4; ++rq) { const size_t off = tok * DI + hh * 64 + 32 * pb + 8 * rq + 4 * hi; const v2u zz = *(const GAS v2u*)(sz + off);
                const float y0 = Y[pb][4 * rq] * bf_lo(zz.x), y1 = Y[pb][4 * rq + 1] * bf_hi(zz.x), y2 = Y[pb][4 * rq + 2] * bf_lo(zz.y), y3 = Y[pb][4 * rq + 3] * bf_hi(zz.y);
                ssq += (y0 * y0 + y1 * y1) + (y2 * y2 + y3 * y3);
                v2u w; w.x = pk_bf16(y0, y1); w.y = pk_bf16(y2, y3); *(GAS v2u*)(yp + off) = w; }
        ssq += __shfl_xor(ssq, 32);
        if (hi == 0) ssqx[hl * 128 + l] = ssq;
    }
    __syncthreads();
    if (tid < 128) { const float s = (ssqx[tid] + ssqx[128 + tid]) + (ssqx[256 + tid] + ssqx[384 + tid]);
        ((float*)(a.ws + WS_SSQ))[(size_t)(t0 + tid) * 8 + 2 * g + hhalf] = s; }
    __syncthreads();
}

__device__ __forceinline__ void final_norm(const Args& a, int vcu, int G) {
    const int tid = threadIdx.x, lane = tid & 63, wave = tid >> 6; const int gw = vcu * NWAVES + wave, NGW = G * NWAVES;
    const float* ss3 = (const float*)(a.ws + WS_SS3); const GAS f32x4* gf = (const GAS f32x4*)a.in[I_GFIN] + lane;
    for (int m = gw; m < M; m += NGW) {
        const f32x4 s0 = *(const GAS f32x4*)(ss3 + (size_t)m * 8), s1 = *(const GAS f32x4*)(ss3 + (size_t)m * 8 + 4);
        const float r = rsqrtf((((s0[0] + s0[1]) + (s0[2] + s0[3])) + ((s1[0] + s1[1]) + (s1[2] + s1[3]))) * (1.f / DM) + 1e-6f);
        GAS f32x4* o = (GAS f32x4*)(a.out + (size_t)m * DM) + lane;
#pragma unroll
        for (int j = 0; j < 8; ++j) { f32x4 v = o[64 * j]; const f32x4 gg = gf[64 * j]; v = v * gg * r; o[64 * j] = v; }
    }
}

__global__ void __launch_bounds__(NTHREADS, 2) mk_fwd(Args args) {
    extern __shared__ __attribute__((aligned(16))) unsigned char lds_raw[];
    LAS unsigned char* lds = (LAS unsigned char*)lds_raw;
    volatile LAS unsigned* MISC = (volatile LAS unsigned*)(lds + MISC_OFF);
    const int tid = threadIdx.x;
    const int G = gridDim.x; const int bx = blockIdx.x; const int vcu = (G % 8 == 0) ? (bx % 8) * (G / 8) + bx / 8 : bx;
    unsigned char* ws = args.ws;
    for (int u = tid; u < 64; u += NTHREADS) MISC[u] = 0u;
    __syncthreads();
    XcdBarrier bar; bar.bar = (unsigned*)(ws + WS_CTL) + CW_BAR; bar.x = 0; bar.st = nullptr;
    if (MK_N_LAUNCHES == 1) bar = xcd_barrier_post((unsigned*)(ws + WS_CTL) + CW_BAR, MISC + 8);
    const int lo = args.ph_lo, hi = args.ph_hi;
#ifndef PHMASK
#define PHMASK 0x7ff
#endif
#define IN(k) (((PHMASK >> (k)) & 1) && lo <= (k) && (k) < hi)
#define SEAM(k) do { if (IN(k) && IN((k) + 1)) { if ((k) == 0) cg::this_grid().sync(); else xcd_barrier(bar); } } while (0)
    using pg8::Gemm; using pg8::StaticOrder; using pg8::gemm_phase; using pg8::EpiProj; using pg8::EpiGateA; using pg8::EpiGateS; using pg8::EpiRes; using pg8::EpiGU; using pg8::EpiF32; using pg8::bf16_t;
    PG8_LAS unsigned char* ring = (PG8_LAS unsigned char*)lds;
    PG8_LAS float* xl = (PG8_LAS float*)(lds + XLDS_OFF);

    if (IN(0)) { p0_prologue(args, lds, vcu, G); }
    SEAM(0);
    if (IN(1)) {
        Gemm g{(const bf16_t*)(ws + WS_U), (const bf16_t*)(ws + WS_WIN), M, NINP, DM}; StaticOrder S; S.init(M, NINP, G, bx);
        EpiProj E{(bf16_t*)(ws + WS_Q), (bf16_t*)(ws + WS_K), (bf16_t*)(ws + WS_V), (bf16_t*)(ws + WS_SZ), (bf16_t*)(ws + WS_XBC), (bf16_t*)args.out, (bf16_t*)args.out + (size_t)M * DM,
                  (float*)(ws + WS_DT), (const float*)(ws + WS_CS), (const float*)args.in[I_DTB]};
        gemm_phase<EpiProj, StaticOrder, true, true>(ring, g, S, E);
    }
    SEAM(1);
    if (IN(2)) {
        for (int u = vcu; u < BATCH * NCH * 4; u += G) attn_unit(args, lds, u);
        for (int u = vcu; u < BATCH * NCH * 4; u += G) ssd_states_unit(args, lds, u);
    }
    SEAM(2);
    if (IN(3)) { ssd_scan(args, vcu, G); }
    SEAM(3);
    if (IN(4)) { static_assert(S3_END <= MISC_OFF, "S3 LDS"); for (int u = vcu; u < BATCH * NCH * 8; u += G) ssd_out_unit(args, lds, u); }
    SEAM(4);
    if (IN(5)) {
        { Gemm g{(const bf16_t*)(ws + WS_ATTN), (const bf16_t*)(ws + WS_WATTN), M, DM, QD}; StaticOrder S; S.init(M, DM, G, bx);
          EpiGateA E{(const bf16_t*)args.out, (float*)(ws + WS_TMP)};
          gemm_phase<EpiGateA, StaticOrder, true, true>(ring, g, S, E); }
        { Gemm g{(const bf16_t*)(ws + WS_YP), (const bf16_t*)(ws + WS_WSSD), M, DM, DI}; StaticOrder S; S.init(M, DM, G, bx);
          EpiGateS E{(const bf16_t*)args.out + (size_t)M * DM, (const float*)(ws + WS_TMP), (const float*)(ws + WS_SSQ), (bf16_t*)(ws + WS_MERGED)};
          gemm_phase<EpiGateS, StaticOrder, true, true>(ring, g, S, E); }
    }
    SEAM(5);
    if (IN(6)) {
        Gemm g{(const bf16_t*)(ws + WS_MERGED), (const bf16_t*)(ws + WS_WO), M, DM, DM}; StaticOrder S; S.init(M, DM, G, bx);
        EpiRes<0> E{(const float*)args.in[I_X], args.out, (bf16_t*)(ws + WS_H1B), (float*)(ws + WS_SS1), nullptr, nullptr, xl, 0.f};
        gemm_phase<EpiRes<0>, StaticOrder, true, true>(ring, g, S, E);
    }
    SEAM(6);
    if (IN(7)) {
        Gemm g{(const bf16_t*)(ws + WS_H1B), (const bf16_t*)(ws + WS_WGU), M, 2 * FF, DM}; StaticOrder S; S.init(M, 2 * FF, G, bx);
        EpiGU E{(const float*)(ws + WS_SS1), (bf16_t*)(ws + WS_ACT), 1e-6f};
        gemm_phase<EpiGU, StaticOrder, true, true>(ring, g, S, E);
    }
    SEAM(7);
    if (IN(8)) {
        Gemm g{(const bf16_t*)(ws + WS_ACT), (const bf16_t*)(ws + WS_WDOWN), M, DM, FF}; StaticOrder S; S.init(M, DM, G, bx);
        EpiRes<0> E{args.out, args.out, (bf16_t*)(ws + WS_H2B), (float*)(ws + WS_SS2), nullptr, nullptr, xl, 0.f};
        gemm_phase<EpiRes<0>, StaticOrder, true, true>(ring, g, S, E);
    }
    SEAM(8);
    if (IN(9)) {
        { int kp = PLE; asm volatile("" : "+s"(kp));
          Gemm g{(const bf16_t*)(ws + WS_PB), (const bf16_t*)(ws + WS_WPP), M, DM, kp}; StaticOrder S; S.init(M, DM, G, bx);
          EpiF32 E{(float*)(ws + WS_TMP)};
          gemm_phase<EpiF32, StaticOrder, true, true>(ring, g, S, E); }
        { Gemm g{(const bf16_t*)(ws + WS_H2B), (const bf16_t*)(ws + WS_WPG), M, DM, DM}; StaticOrder S; S.init(M, DM, G, bx);
          EpiRes<1> E{args.out, args.out, nullptr, (float*)(ws + WS_SS3), (const float*)(ws + WS_SS2), (const float*)(ws + WS_TMP), xl, 1e-6f};
          gemm_phase<EpiRes<1>, StaticOrder, true, true>(ring, g, S, E); }
    }
    SEAM(9);
    if (IN(10)) { final_norm(args, vcu, G); }
#undef IN
#undef SEAM
}

extern "C" void kernel_launch(void* const* d_in, const int* in_sizes, int n_in, void* d_out, int out_size, void* d_ws, size_t ws_size, hipStream_t stream) {
    static int grid = 0;
    if (grid == 0) {
        if (n_in != N_IN || in_sizes[0] != M * DM || out_size != M * DM || ws_size < WS_END) {
            fprintf(stderr, "kernel_launch: shape/workspace mismatch (n_in %d, in0 %d, out %d, ws %zu, need %zu); nothing launched\n", n_in, n_in > 0 ? in_sizes[0] : -1, out_size, ws_size, (size_t)WS_END); grid = -1; return; }
        int dev = 0, cus = 0, per_cu = 0;
        hipGetDevice(&dev); hipDeviceGetAttribute(&cus, hipDeviceAttributeMultiprocessorCount, dev);
        if (hipFuncSetAttribute((const void*)mk_fwd, hipFuncAttributeMaxDynamicSharedMemorySize, LDS_BYTES) != hipSuccess) { fprintf(stderr, "kernel_launch: hipFuncSetAttribute failed\n"); grid = -1; return; }
        if (hipOccupancyMaxActiveBlocksPerMultiprocessor(&per_cu, (const void*)mk_fwd, NTHREADS, LDS_BYTES) != hipSuccess || per_cu < 1) { fprintf(stderr, "kernel_launch: occupancy query failed (%d)\n", per_cu); (void)hipGetLastError(); per_cu = 1; }
        grid = cus * (per_cu >= 1 ? 1 : 1);
        fprintf(stderr, "kernel_launch: cus %d per_cu %d grid %d ws %zu\n", cus, per_cu, grid, ws_size);
    }
    if (grid < 0) return;
    hipMemsetAsync((char*)d_ws + WS_CTL, 0, CTL_ZERO_BYTES, stream);
    Args a{};
    for (int i = 0; i < N_IN; ++i) a.in[i] = d_in[i];
    a.out = (float*)d_out; a.ws = (unsigned char*)d_ws;
#if MK_N_LAUNCHES == 1
    a.ph_lo = 0; a.ph_hi = NPHASE;
    void* kargs[] = {&a};
    hipError_t e = hipLaunchCooperativeKernel((const void*)mk_fwd, dim3(grid), dim3(NTHREADS), kargs, LDS_BYTES, stream);
    if (e != hipSuccess) fprintf(stderr, "kernel_launch: cooperative launch failed: %s (grid %d)\n", hipGetErrorString(e), grid);
#else
    for (int ph = 0; ph < NPHASE; ++ph) { a.ph_lo = ph; a.ph_hi = ph + 1; hipLaunchKernelGGL(mk_fwd, dim3(grid), dim3(NTHREADS), LDS_BYTES, stream, a); }
#endif
}
```

```cpp
#include <hip/hip_runtime.h>
#include <hip/hip_cooperative_groups.h>
#include <cstdio>
#include <cstdint>
namespace cg = cooperative_groups;
namespace pg8 {
#define PG8_LAS __attribute__((address_space(3)))
typedef unsigned short bf16_t;
typedef short bf16x8 __attribute__((ext_vector_type(8)));
typedef float f32x4 __attribute__((ext_vector_type(4)));
typedef unsigned u32x4 __attribute__((ext_vector_type(4)));
constexpr int BM = 256, BK = 64, HALF = 128, HTB = HALF * BK * 2  , STAGE_BYTES = 8 * HTB, NXCD = 8, WGM = 8;

__host__ __device__ __forceinline__ int lds_byte(int r, int c) { const int st = (r >> 4) * 2 + (c >> 5), rr = r & 15, cc = c & 31, ob = rr * 64 + cc * 2; return st * 1024 + (ob ^ (((ob >> 9) & 1) << 5)); }
__host__ __device__ __forceinline__ void stage_rc(int b, int& R, int& C) { const int st = b / 1024, sb = b % 1024, swz = sb ^ (((sb >> 9) & 1) << 5); R = (st >> 1) * 16 + swz / 64; C = (st & 1) * 32 + (swz % 64) / 2; }
__host__ __device__ __forceinline__ int perm32(int rho) { const int n = rho >> 4, i = rho & 15; return 8 * (i >> 2) + 4 * n + (i & 3); }

struct Unit { int pm, pn; };
struct Gemm { const bf16_t* A; const bf16_t* Bt; int M, N, K; };

struct StaticOrder {
    int nM, nN, nwg, G, c;
    __host__ __device__ void init(int M, int N, int G_, int c_) { nM = M / BM; nN = N / BM; nwg = nM * nN; G = G_; c = c_; }
    __host__ __device__ bool next(int i, Unit& u) const {
        const long L = (long)i * G + c; if (L >= nwg) return false;
        int wgid = (int)L; { const int q = nwg / NXCD, r = nwg % NXCD, xcd = wgid % NXCD, off = wgid / NXCD; wgid = (xcd < r ? xcd * (q + 1) : r * (q + 1) + (xcd - r) * q) + off; }
        const int nig = WGM * nN, gid = wgid / nig, fm = gid * WGM, gsz = (nM - fm) < WGM ? (nM - fm) : WGM;
        u.pm = fm + ((wgid % nig) % gsz); u.pn = (wgid % nig) / gsz; return true;
    }
    __device__ __forceinline__ void a_ready(const Unit&) const {}
    __device__ __forceinline__ void done(const Unit&) const {}
};


typedef unsigned u32x2 __attribute__((ext_vector_type(2)));
typedef float f32x2v __attribute__((ext_vector_type(2)));
typedef __bf16 bf16x2v __attribute__((ext_vector_type(2)));
__device__ __forceinline__ unsigned pk_bf16(float lo, float hi) { f32x2v v = {lo, hi}; bf16x2v b = __builtin_convertvector(v, bf16x2v); return __builtin_bit_cast(unsigned, b); }
__device__ __forceinline__ float bf_lo(unsigned u) { return __uint_as_float(u << 16); }
__device__ __forceinline__ float bf_hi(unsigned u) { return __uint_as_float(u & 0xffff0000u); }
__device__ __forceinline__ float sigmoid_f(float x) { return __builtin_amdgcn_rcpf(1.f + __expf(-x)); }
__device__ __forceinline__ float silu_f(float x) { return x * sigmoid_f(x); }
__device__ __forceinline__ float softplus_f(float x) { return x > 20.f ? x : log1pf(expf(x)); }
constexpr float QSCALE = 0.125f * 1.4426950408889634f;


struct EpiProj {
    static constexpr bool PERM = true, AFTER_DRAIN = false;
    bf16_t *q, *k, *v, *sz, *xbc, *ga, *gs; float* dt; const float* cs; const float* dt_bias;
    template <int MODE> __device__ __forceinline__ void plain(const f32x4 (&acc)[2][2][4][2], bf16_t* dst, int ld, int row0, int cw) const {
#pragma unroll
        for (int ai = 0; ai < 2; ++ai)
#pragma unroll
            for (int m = 0; m < 4; ++m) { bf16_t* rowp = dst + (size_t)(row0 + ai * HALF + m * 16) * ld + cw;
#pragma unroll
                for (int bj = 0; bj < 2; ++bj) { f32x4 v0 = acc[ai][bj][m][0], v1 = acc[ai][bj][m][1];
                    if (MODE == 1) { for (int e = 0; e < 4; ++e) { v0[e] = silu_f(v0[e]); v1[e] = silu_f(v1[e]); } }
                    if (MODE == 2) { for (int e = 0; e < 4; ++e) { v0[e] = sigmoid_f(v0[e]); v1[e] = sigmoid_f(v1[e]); } }
                    u32x4 w; w.x = pk_bf16(v0[0], v0[1]); w.y = pk_bf16(v0[2], v0[3]); w.z = pk_bf16(v1[0], v1[1]); w.w = pk_bf16(v1[2], v1[3]);
                    *(u32x4*)(rowp + bj * HALF) = w; } }
    }
    __device__ __forceinline__ void operator()(const f32x4 (&acc)[2][2][4][2], const Unit& u, int wr, int wc, int fr, int fq) const {
        const int pn = u.pn, row0 = u.pm * BM + wr * 64 + fr, cw = wc * 32 + 8 * fq;
        if (pn < 5) {
            bf16_t* dst = pn < 4 ? q + pn * 256 : k; const int ld = pn < 4 ? 1024 : 256; const float sc = pn < 4 ? QSCALE : 1.f;
            const int i0 = (wc & 1) * 16 + 4 * fq;
#pragma unroll
            for (int ai = 0; ai < 2; ++ai)
#pragma unroll
                for (int m = 0; m < 4; ++m) { const int row = row0 + ai * HALF + m * 16;
                    const f32x4* t = (const f32x4*)(cs + ((size_t)row * 32 + i0) * 2); const f32x4 t0 = t[0], t1 = t[1];
#pragma unroll
                    for (int bj = 0; bj < 2; ++bj) { const f32x4 v0 = acc[ai][bj][m][0], v1 = acc[ai][bj][m][1];
                        const float o0 = (v0[0] * t0[0] - v0[1] * t0[1]) * sc, o1 = (v0[1] * t0[0] + v0[0] * t0[1]) * sc;
                        const float o2 = (v0[2] * t0[2] - v0[3] * t0[3]) * sc, o3 = (v0[3] * t0[2] + v0[2] * t0[3]) * sc;
                        const float o4 = (v1[0] * t1[0] - v1[1] * t1[1]) * sc, o5 = (v1[1] * t1[0] + v1[0] * t1[1]) * sc;
                        const float o6 = (v1[2] * t1[2] - v1[3] * t1[3]) * sc, o7 = (v1[3] * t1[2] + v1[2] * t1[3]) * sc;
                        u32x4 w; w.x = pk_bf16(o0, o1); w.y = pk_bf16(o2, o3); w.z = pk_bf16(o4, o5); w.w = pk_bf16(o6, o7);
                        *(u32x4*)(dst + (size_t)row * ld + bj * HALF + cw) = w; } }
        } else if (pn == 5) plain<0>(acc, v, 256, row0, cw);
        else if (pn < 14) plain<1>(acc, sz + (pn - 6) * 256, 2048, row0, cw);
        else if (pn < 26) plain<0>(acc, xbc + (pn - 14) * 256, 3072, row0, cw);
        else if (pn < 34) plain<2>(acc, ga + (pn - 26) * 256, 2048, row0, cw);
        else if (pn < 42) plain<2>(acc, gs + (pn - 34) * 256, 2048, row0, cw);
        else if (wc == 0) {
            const f32x4 b0 = *(const f32x4*)(dt_bias + 8 * fq), b1 = *(const f32x4*)(dt_bias + 8 * fq + 4);
#pragma unroll
            for (int ai = 0; ai < 2; ++ai)
#pragma unroll
                for (int m = 0; m < 4; ++m) { float* rowp = dt + (size_t)(row0 + ai * HALF + m * 16) * 32 + 8 * fq;
                    f32x4 v0 = acc[ai][0][m][0] + b0, v1 = acc[ai][0][m][1] + b1;
                    for (int e = 0; e < 4; ++e) { v0[e] = softplus_f(v0[e]); v1[e] = softplus_f(v1[e]); }
                    *(f32x4*)rowp = v0; *(f32x4*)(rowp + 4) = v1; }
        }
    }
};

struct EpiGateA {
    static constexpr bool PERM = true, AFTER_DRAIN = false;
    const bf16_t* ga; float* tmp;
    __device__ __forceinline__ void operator()(const f32x4 (&acc)[2][2][4][2], const Unit& u, int wr, int wc, int fr, int fq) const {
        const int row0 = u.pm * BM + wr * 64 + fr, col0 = u.pn * BM + wc * 32 + 8 * fq;
#pragma unroll
        for (int ai = 0; ai < 2; ++ai)
#pragma unroll
            for (int m = 0; m < 4; ++m) { const size_t off = (size_t)(row0 + ai * HALF + m * 16) * 2048 + col0;
#pragma unroll
                for (int bj = 0; bj < 2; ++bj) { const u32x4 g = *(const u32x4*)(ga + off + bj * HALF);
                    f32x4 v0 = acc[ai][bj][m][0], v1 = acc[ai][bj][m][1];
                    v0[0] *= bf_lo(g.x); v0[1] *= bf_hi(g.x); v0[2] *= bf_lo(g.y); v0[3] *= bf_hi(g.y); v1[0] *= bf_lo(g.z); v1[1] *= bf_hi(g.z); v1[2] *= bf_lo(g.w); v1[3] *= bf_hi(g.w);
                    *(f32x4*)(tmp + off + bj * HALF) = v0; *(f32x4*)(tmp + off + bj * HALF + 4) = v1; } }
    }
};
struct EpiGateS {
    static constexpr bool PERM = true, AFTER_DRAIN = false;
    const bf16_t* gs; const float* tmp; const float* ssq; bf16_t* merged;
    __device__ __forceinline__ void operator()(const f32x4 (&acc)[2][2][4][2], const Unit& u, int wr, int wc, int fr, int fq) const {
        const int row0 = u.pm * BM + wr * 64 + fr, col0 = u.pn * BM + wc * 32 + 8 * fq;
#pragma unroll
        for (int ai = 0; ai < 2; ++ai)
#pragma unroll
            for (int m = 0; m < 4; ++m) { const int row = row0 + ai * HALF + m * 16; const size_t off = (size_t)row * 2048 + col0;
                const f32x4 s4 = *(const f32x4*)(ssq + (size_t)row * 8), s5 = *(const f32x4*)(ssq + (size_t)row * 8 + 4);
                const float r = rsqrtf((((s4[0] + s4[1]) + (s4[2] + s4[3])) + ((s5[0] + s5[1]) + (s5[2] + s5[3]))) * (1.f / 2048.f) + 1e-5f);
#pragma unroll
                for (int bj = 0; bj < 2; ++bj) { const u32x4 g = *(const u32x4*)(gs + off + bj * HALF);
                    const f32x4 t0 = *(const f32x4*)(tmp + off + bj * HALF), t1 = *(const f32x4*)(tmp + off + bj * HALF + 4);
                    f32x4 v0 = acc[ai][bj][m][0] * r, v1 = acc[ai][bj][m][1] * r;
                    v0[0] = t0[0] + v0[0] * bf_lo(g.x); v0[1] = t0[1] + v0[1] * bf_hi(g.x); v0[2] = t0[2] + v0[2] * bf_lo(g.y); v0[3] = t0[3] + v0[3] * bf_hi(g.y);
                    v1[0] = t1[0] + v1[0] * bf_lo(g.z); v1[1] = t1[1] + v1[1] * bf_hi(g.z); v1[2] = t1[2] + v1[2] * bf_lo(g.w); v1[3] = t1[3] + v1[3] * bf_hi(g.w);
                    u32x4 w; w.x = pk_bf16(v0[0], v0[1]); w.y = pk_bf16(v0[2], v0[3]); w.z = pk_bf16(v1[0], v1[1]); w.w = pk_bf16(v1[2], v1[3]);
                    *(u32x4*)(merged + off + bj * HALF) = w; } }
    }
};
template <int MODE> struct EpiRes {
    static constexpr bool PERM = false, AFTER_DRAIN = false;
    const float* res; float* out; bf16_t* hb; float* ss; const float* ssin; const float* tmp; PG8_LAS float* xlds; float eps;
    __device__ __forceinline__ void operator()(const f32x4 (&acc)[2][2][4][2], const Unit& u, int wr, int wc, int fr, int fq) const {
        const int row0 = u.pm * BM + wr * 64 + fr, col0 = u.pn * BM + wc * 32 + 4 * fq;
#pragma unroll
        for (int ai = 0; ai < 2; ++ai)
#pragma unroll
            for (int m = 0; m < 4; ++m) { const int row = row0 + ai * HALF + m * 16; const size_t off = (size_t)row * 2048 + col0; float s = 0.f, r = 1.f;
                if (MODE == 1) { const f32x4 a = *(const f32x4*)(ssin + (size_t)row * 8), b = *(const f32x4*)(ssin + (size_t)row * 8 + 4);
                    r = rsqrtf((((a[0] + a[1]) + (a[2] + a[3])) + ((b[0] + b[1]) + (b[2] + b[3]))) * (1.f / 2048.f) + eps); }
#pragma unroll
                for (int bj = 0; bj < 2; ++bj)
#pragma unroll
                    for (int n = 0; n < 2; ++n) { const size_t o = off + bj * HALF + n * 16; f32x4 h = *(const f32x4*)(res + o); f32x4 a = acc[ai][bj][m][n];
                        if (MODE == 1) { const f32x4 t = *(const f32x4*)(tmp + o); for (int e = 0; e < 4; ++e) a[e] = sigmoid_f(a[e] * r) * t[e]; }
                        h = h + a; *(f32x4*)(out + o) = h;
                        if (hb) { u32x2 w; w.x = pk_bf16(h[0], h[1]); w.y = pk_bf16(h[2], h[3]); *(u32x2*)(hb + o) = w; }
                        s += (h[0] * h[0] + h[1] * h[1]) + (h[2] * h[2] + h[3] * h[3]);
                        if (MODE == 1) asm volatile("" ::: "memory"); }
                s += __shfl_xor(s, 16); s += __shfl_xor(s, 32);
                if (fq == 0) xlds[(ai * HALF + wr * 64 + m * 16 + fr) * 4 + wc] = s;
                if (MODE == 1) asm volatile("" ::: "memory"); }
        asm volatile("s_waitcnt lgkmcnt(0)" ::: "memory"); __builtin_amdgcn_s_barrier(); asm volatile("" ::: "memory");
        const int t = threadIdx.x;
        if (t < 256) { const f32x4 x = *(const PG8_LAS f32x4*)(xlds + t * 4); ss[(size_t)(u.pm * BM + t) * 8 + u.pn] = (x[0] + x[1]) + (x[2] + x[3]); }
    }
};
struct EpiGU {
    static constexpr bool PERM = true, AFTER_DRAIN = false;
    const float* ssin; bf16_t* act; float eps;
    __device__ __forceinline__ void operator()(const f32x4 (&acc)[2][2][4][2], const Unit& u, int wr, int wc, int fr, int fq) const {
        const int row0 = u.pm * BM + wr * 64 + fr, col0 = u.pn * HALF + wc * 32 + 8 * fq;
#pragma unroll
        for (int ai = 0; ai < 2; ++ai)
#pragma unroll
            for (int m = 0; m < 4; ++m) { const int row = row0 + ai * HALF + m * 16;
                const f32x4 a = *(const f32x4*)(ssin + (size_t)row * 8), b = *(const f32x4*)(ssin + (size_t)row * 8 + 4);
                const float r = rsqrtf((((a[0] + a[1]) + (a[2] + a[3])) + ((b[0] + b[1]) + (b[2] + b[3]))) * (1.f / 2048.f) + eps);
                const f32x4 g0 = acc[ai][0][m][0] * r, g1 = acc[ai][0][m][1] * r, u0 = acc[ai][1][m][0] * r, u1 = acc[ai][1][m][1] * r;
                u32x4 w; w.x = pk_bf16(silu_f(g0[0]) * u0[0], silu_f(g0[1]) * u0[1]); w.y = pk_bf16(silu_f(g0[2]) * u0[2], silu_f(g0[3]) * u0[3]);
                w.z = pk_bf16(silu_f(g1[0]) * u1[0], silu_f(g1[1]) * u1[1]); w.w = pk_bf16(silu_f(g1[2]) * u1[2], silu_f(g1[3]) * u1[3]);
                *(u32x4*)(act + (size_t)row * 5632 + col0) = w; }
    }
};
struct EpiF32 {
    static constexpr bool PERM = false, AFTER_DRAIN = false;
    float* C;
    __device__ __forceinline__ void operator()(const f32x4 (&acc)[2][2][4][2], const Unit& u, int wr, int wc, int fr, int fq) const {
        const int row0 = u.pm * BM + wr * 64 + fr, col0 = u.pn * BM + wc * 32 + 4 * fq;
#pragma unroll
        for (int ai = 0; ai < 2; ++ai)
#pragma unroll
            for (int m = 0; m < 4; ++m) { float* rowp = C + (size_t)(row0 + ai * HALF + m * 16) * 2048 + col0;
#pragma unroll
                for (int bj = 0; bj < 2; ++bj)
#pragma unroll
                    for (int n = 0; n < 2; ++n) *(f32x4*)(rowp + bj * HALF + n * 16) = acc[ai][bj][m][n]; }
    }
};
template <class Epi, class Sched, bool ALIGN_EPI = false, bool SP2 = false>
__device__ __forceinline__ void gemm_phase(PG8_LAS unsigned char* lds, const Gemm g, const Sched& S, const Epi& E) {
    const int tid = threadIdx.x, wid = __builtin_amdgcn_readfirstlane(tid >> 6), lane = tid & 63, wr = wid >> 2, wc = wid & 3, fr = lane & 15, fq = lane >> 4;
    const int K = g.K, nt = K / BK;
    unsigned voffA[2], voffB[2];
#pragma unroll
    for (int i = 0; i < 2; ++i) { int R, C; stage_rc(tid * 16 + i * 8192, R, C); const int Rb = Epi::PERM ? ((R & ~31) + perm32(R & 31)) : R;
        voffA[i] = (unsigned)(R * K + C) * 2u; voffB[i] = (unsigned)(Rb * K + C) * 2u; }
    const size_t kstep = (size_t)(BK * 2);
    const size_t hstep = (size_t)HALF * K * 2;
    const size_t tstep = 2 * hstep;
    const unsigned ldsw = (unsigned)wid * 1024u;
    const int aoff = lds_byte(wr * 64 + fr, fq * 8), boff = lds_byte(wc * 32 + fr, fq * 8);
#define PG8_SA(b, h) (((b) * 2 + (h)) * HTB)
#define PG8_SB(b, h) ((4 + (b) * 2 + (h)) * HTB)
#define PG8_STAGE(bufoff, gbase, voff) do { _Pragma("unroll") for (int _i = 0; _i < 2; ++_i) \
        __builtin_amdgcn_global_load_lds((const unsigned*)((const char*)(gbase) + (voff)[_i]), (PG8_LAS unsigned*)(lds + (bufoff) + ldsw + _i * 8192), 16, 0, 0); } while (0)
#define PG8_LDA(dst, b, h) do { _Pragma("unroll") for (int m = 0; m < 4; ++m) _Pragma("unroll") for (int k = 0; k < 2; ++k) dst[m][k] = *(const PG8_LAS bf16x8*)(lds + PG8_SA(b, h) + aoff + m * 2048 + k * 1024); } while (0)
#define PG8_LDB(dst, b, h) do { _Pragma("unroll") for (int n = 0; n < 2; ++n) _Pragma("unroll") for (int k = 0; k < 2; ++k) dst[n][k] = *(const PG8_LAS bf16x8*)(lds + PG8_SB(b, h) + boff + n * 2048 + k * 1024); } while (0)
#define PG8_MMA(ai, bj, At, Bt) do { __builtin_amdgcn_s_setprio(1); _Pragma("unroll") for (int m = 0; m < 4; ++m) _Pragma("unroll") for (int n = 0; n < 2; ++n) _Pragma("unroll") for (int k = 0; k < 2; ++k) \
        acc[ai][bj][m][n] = __builtin_amdgcn_mfma_f32_16x16x32_bf16(Bt[n][k], At[m][k], acc[ai][bj][m][n], 0, 0, 0); __builtin_amdgcn_s_setprio(0); } while (0)
#define PG8_WAIT_V(n) asm volatile("s_waitcnt vmcnt(" #n ")" ::: "memory")
#define PG8_WAIT_L(n) asm volatile("s_waitcnt lgkmcnt(" #n ")" ::: "memory")
#define PG8_BAR __builtin_amdgcn_s_barrier()
#define PG8_SCHED __builtin_amdgcn_sched_barrier(0)
    Unit cur, nxt; int ui = 0;
    if (!S.next(0, cur)) return;
    f32x4 acc[2][2][4][2];
#pragma unroll
    for (int a = 0; a < 2; ++a)
#pragma unroll
        for (int b = 0; b < 2; ++b)
#pragma unroll
            for (int m = 0; m < 4; ++m)
#pragma unroll
                for (int n = 0; n < 2; ++n) acc[a][b][m][n] = (f32x4){0.f, 0.f, 0.f, 0.f};
    bf16x8 At[4][2], B0[2][2], B1[2][2];
    const char* cA = (const char*)g.A + (size_t)cur.pm * tstep; const char* cB = (const char*)g.Bt + (size_t)cur.pn * tstep;
    S.a_ready(cur);
    if constexpr (SP2) {
        PG8_STAGE(PG8_SB(0, 0), cB, voffB); PG8_STAGE(PG8_SB(0, 1), cB + hstep, voffB); PG8_STAGE(PG8_SA(0, 0), cA, voffA); PG8_STAGE(PG8_SA(0, 1), cA + hstep, voffA);
        if (wr == 1) PG8_BAR;
        PG8_WAIT_V(2); PG8_BAR;
        PG8_STAGE(PG8_SB(1, 0), cB + kstep, voffB); PG8_STAGE(PG8_SA(1, 0), cA + kstep, voffA); PG8_STAGE(PG8_SB(1, 1), cB + hstep + kstep, voffB);
        PG8_WAIT_V(6); PG8_BAR;
    } else {
        PG8_STAGE(PG8_SB(0, 0), cB, voffB); PG8_STAGE(PG8_SA(0, 0), cA, voffA); PG8_STAGE(PG8_SB(0, 1), cB + hstep, voffB); PG8_STAGE(PG8_SA(0, 1), cA + hstep, voffA);
        if (wr == 1) PG8_BAR;
        PG8_WAIT_V(4); PG8_BAR;
        PG8_STAGE(PG8_SB(1, 0), cB + kstep, voffB); PG8_STAGE(PG8_SA(1, 0), cA + kstep, voffA); PG8_STAGE(PG8_SB(1, 1), cB + hstep + kstep, voffB);
        PG8_WAIT_V(6); PG8_BAR;
    }
    for (;;) {
        const bool has_next = S.next(ui + 1, nxt);
        const char* nA = has_next ? (const char*)g.A + (size_t)nxt.pm * tstep : cA; const char* nB = has_next ? (const char*)g.Bt + (size_t)nxt.pn * tstep : cB;
        for (int t = 0; t < nt; t += 2) {
            const bool last = (t == nt - 2);
            const char* a1 = cA + (size_t)(t + 1) * kstep;
            const char* a2 = last ? nA : cA + (size_t)(t + 2) * kstep; const char* b2 = last ? nB : cB + (size_t)(t + 2) * kstep;
            const char* a3 = a2 + kstep; const char* b3 = b2 + kstep;
            if (last && has_next) S.a_ready(nxt);
            if constexpr (SP2) {
            PG8_LDB(B0, 0, 0); PG8_LDB(B1, 0, 1); PG8_SCHED; PG8_LDA(At, 0, 0); PG8_STAGE(PG8_SA(1, 1), a1 + hstep, voffA);
            PG8_WAIT_V(8); PG8_WAIT_L(0); PG8_BAR; PG8_MMA(0, 0, At, B0); PG8_MMA(0, 1, At, B1); PG8_BAR; PG8_SCHED;
            PG8_LDA(At, 0, 1); PG8_STAGE(PG8_SB(0, 0), b2, voffB); PG8_STAGE(PG8_SB(0, 1), b2 + hstep, voffB); PG8_STAGE(PG8_SA(0, 0), a2, voffA);
            PG8_WAIT_V(8); PG8_WAIT_L(0); PG8_BAR; PG8_MMA(1, 0, At, B0); PG8_MMA(1, 1, At, B1); PG8_BAR; PG8_SCHED;
            PG8_LDB(B0, 1, 0); PG8_LDB(B1, 1, 1); PG8_SCHED; PG8_LDA(At, 1, 0); PG8_STAGE(PG8_SA(0, 1), a2 + hstep, voffA);
            PG8_WAIT_V(8); PG8_WAIT_L(0); PG8_BAR; PG8_MMA(0, 0, At, B0); PG8_MMA(0, 1, At, B1); PG8_BAR; PG8_SCHED;
            PG8_LDA(At, 1, 1); PG8_STAGE(PG8_SB(1, 0), b3, voffB); PG8_STAGE(PG8_SB(1, 1), b3 + hstep, voffB); PG8_STAGE(PG8_SA(1, 0), a3, voffA);
            PG8_WAIT_V(8); PG8_WAIT_L(0); PG8_BAR; PG8_MMA(1, 0, At, B0); PG8_MMA(1, 1, At, B1); PG8_BAR; PG8_SCHED;
            } else {
            PG8_LDB(B0, 0, 0); PG8_SCHED; PG8_LDA(At, 0, 0); PG8_STAGE(PG8_SA(1, 1), a1 + hstep, voffA);
            PG8_WAIT_L(8); PG8_BAR; PG8_WAIT_L(0); PG8_MMA(0, 0, At, B0); PG8_BAR; PG8_SCHED;
            PG8_LDB(B1, 0, 1); PG8_STAGE(PG8_SB(0, 0), b2, voffB);
            PG8_BAR; PG8_WAIT_L(0); PG8_MMA(0, 1, At, B1); PG8_BAR;
            PG8_LDA(At, 0, 1); PG8_STAGE(PG8_SA(0, 0), a2, voffA);
            PG8_BAR; PG8_WAIT_L(0); PG8_MMA(1, 0, At, B0); PG8_BAR; PG8_SCHED;
            PG8_STAGE(PG8_SB(0, 1), b2 + hstep, voffB);
            PG8_WAIT_V(6); PG8_BAR; PG8_MMA(1, 1, At, B1); PG8_BAR;
            PG8_LDB(B0, 1, 0); PG8_SCHED; PG8_LDA(At, 1, 0); PG8_STAGE(PG8_SA(0, 1), a2 + hstep, voffA);
            PG8_WAIT_L(8); PG8_BAR; PG8_WAIT_L(0); PG8_MMA(0, 0, At, B0); PG8_BAR; PG8_SCHED;
            PG8_LDB(B1, 1, 1); PG8_STAGE(PG8_SB(1, 0), b3, voffB);
            PG8_BAR; PG8_WAIT_L(0); PG8_MMA(0, 1, At, B1); PG8_BAR;
            PG8_LDA(At, 1, 1); PG8_STAGE(PG8_SA(1, 0), a3, voffA);
            PG8_BAR; PG8_WAIT_L(0); PG8_MMA(1, 0, At, B0); PG8_BAR; PG8_SCHED;
            PG8_STAGE(PG8_SB(1, 1), b3 + hstep, voffB);
            PG8_WAIT_V(6); PG8_BAR; PG8_MMA(1, 1, At, B1); PG8_BAR;
            }
        }
        if constexpr (ALIGN_EPI) { if (wr == 0) PG8_BAR; }
        if constexpr (!Epi::AFTER_DRAIN) { E(acc, cur, wr, wc, fr, fq); S.done(cur); }
        if (!has_next) break;
#pragma unroll
        for (int a = 0; a < 2; ++a)
#pragma unroll
            for (int b = 0; b < 2; ++b)
#pragma unroll
                for (int m = 0; m < 4; ++m)
#pragma unroll
                    for (int n = 0; n < 2; ++n) acc[a][b][m][n] = (f32x4){0.f, 0.f, 0.f, 0.f};
        cur = nxt; cA = nA; cB = nB; ++ui;
        if constexpr (ALIGN_EPI) { if (wr == 1) PG8_BAR; }
    }
    PG8_WAIT_V(0);
    if constexpr (!ALIGN_EPI) { if (wr == 0) PG8_BAR; }
    PG8_BAR;
    if constexpr (Epi::AFTER_DRAIN) { E.fused(acc, cur, wr, wc, fr, fq, lds, wid, lane); S.done(cur); }
#undef PG8_SA
#undef PG8_SB
#undef PG8_STAGE
#undef PG8_LDA
#undef PG8_LDB
#undef PG8_MMA
#undef PG8_WAIT_V
#undef PG8_WAIT_L
#undef PG8_BAR
#undef PG8_SCHED
}
}

#ifndef MK_N_LAUNCHES
#define MK_N_LAUNCHES 1
#endif
constexpr int NPHASE = 11;
constexpr int NWAVES = 8, NTHREADS = 512;
constexpr int BATCH = 4, SEQ = 2048, DM = 2048, M = BATCH * SEQ;
constexpr int QD = 1024, KVD = 256, DI = 2048, CONVD = 3072, NH = 32, FF = 5632, PLE = 256;
constexpr int NIN = 10784, NINP = 11008;
constexpr int NCH = SEQ / 128;
constexpr size_t MiB = 1u << 20;
constexpr size_t WS_CTL = 0, CTL_ZERO_BYTES = 65536;
constexpr size_t WS_CS = 1 * MiB;
constexpr size_t WS_SSQ = 3 * MiB, WS_SS1 = WS_SSQ + 256 * 1024, WS_SS2 = WS_SS1 + 256 * 1024, WS_SS3 = WS_SS2 + 256 * 1024;
constexpr size_t WS_ACS = 4 * MiB, WS_DT = 5 * MiB;
constexpr size_t WS_WIN = 6 * MiB, WS_U = 49 * MiB;
constexpr size_t WS_WATTN = 81 * MiB, WS_WSSD = 85 * MiB, WS_WO = 93 * MiB, WS_WGU = 101 * MiB, WS_WDOWN = 145 * MiB, WS_WPG = 167 * MiB, WS_WPP = 175 * MiB;
constexpr size_t WS_Q = 176 * MiB, WS_K = 192 * MiB, WS_V = 196 * MiB, WS_SZ = 200 * MiB, WS_XBC = 232 * MiB;
constexpr size_t WS_ATTN = 280 * MiB, WS_PREV = 296 * MiB, WS_PB = 328 * MiB, WS_END = 332 * MiB;
constexpr size_t WS_STATES = 6 * MiB;
constexpr size_t WS_YP = 6 * MiB;
constexpr size_t WS_TMP = 176 * MiB, WS_MERGED = 240 * MiB;
constexpr size_t WS_H1B = 6 * MiB, WS_ACT = 176 * MiB, WS_H2B = 38 * MiB;
static_assert(WS_WIN + (size_t)NINP * DM * 2 <= WS_U && WS_U + (size_t)M * DM * 2 <= WS_WATTN && WS_WPP + (size_t)DM * PLE * 2 <= WS_Q, "ws map 1");
static_assert(WS_XBC + (size_t)M * CONVD * 2 <= WS_ATTN && WS_PB + (size_t)M * PLE * 2 <= WS_END && WS_STATES + (size_t)M / 128 * NH * 8192 * 4 <= WS_WATTN, "ws map 2");
static_assert(WS_ACT + (size_t)M * FF * 2 <= WS_ATTN && WS_MERGED + (size_t)M * DM * 2 <= WS_ATTN && WS_WGU + (size_t)2 * FF * DM * 2 <= WS_WDOWN && WS_WDOWN + (size_t)DM * FF * 2 <= WS_WPG, "ws map 3");
constexpr int CW_BAR = 4096;
constexpr int RING_BYTES = 131072, XLDS_OFF = RING_BYTES, LDS_BYTES = 147456, MISC_OFF = LDS_BYTES - 256;

#define GAS __attribute__((address_space(1)))
#define LAS __attribute__((address_space(3)))
typedef unsigned short bf16;
typedef unsigned v4u __attribute__((ext_vector_type(4)));
typedef unsigned v2u __attribute__((ext_vector_type(2)));
typedef float f32x4 __attribute__((ext_vector_type(4)));
typedef float f32x16 __attribute__((ext_vector_type(16)));
typedef float f32x2p __attribute__((ext_vector_type(2)));
typedef short bf16x8 __attribute__((ext_vector_type(8)));
#define LDS_WAIT() asm volatile("s_waitcnt lgkmcnt(0)" ::: "memory")
#define VM_WAIT() asm volatile("s_waitcnt vmcnt(0)" ::: "memory")
using pg8::pk_bf16; using pg8::bf_lo; using pg8::bf_hi; using pg8::silu_f; using pg8::sigmoid_f;
__device__ __forceinline__ float bf2f(bf16 x) { return __uint_as_float((unsigned)x << 16); }
constexpr float LOG2E = 1.4426950408889634f;

#define XB_TMO      128
#define XB_XCNT(j)  (256  + 64 * (j))
#define XB_XSUB(j)  (1280 + 64 * (j))
#define XB_XGEN(j)  (2304 + 64 * (j))
#define XB_TOP      3328
#define XB_TOPGEN   3392
#define XCD_BAR_WORDS 3456
#define XB_SPIN_CAP (1u << 18)
__device__ __forceinline__ unsigned xb_ld(unsigned* p)              { return __hip_atomic_load(p, __ATOMIC_RELAXED, __HIP_MEMORY_SCOPE_AGENT); }
__device__ __forceinline__ unsigned xb_add(unsigned* p, unsigned v) { return __hip_atomic_fetch_add(p, v, __ATOMIC_RELAXED, __HIP_MEMORY_SCOPE_AGENT); }
__device__ __forceinline__ unsigned xb_xcc_id() { return (unsigned)__builtin_amdgcn_s_getreg((3 << 11) | 20) & 0xFu; }
#define XB_SPIN(cond, bar) do { unsigned _sp = 0; while (cond) { __builtin_amdgcn_s_sleep(1); \
    if ((++_sp & 255u) == 0u) { if (xb_ld(&(bar)[XB_TMO])) break; if (_sp > XB_SPIN_CAP) { atomicAdd(&(bar)[XB_TMO], 1u); break; } } } } while (0)
struct XcdBarrier { unsigned* bar; unsigned x; volatile LAS unsigned* st; };
__device__ __forceinline__ XcdBarrier xcd_barrier_post(unsigned* bar, volatile LAS unsigned* st) {
    XcdBarrier b; b.bar = bar; b.x = xb_xcc_id(); b.st = st;
    if (threadIdx.x == 0) (void)xb_add(&bar[XB_XCNT(b.x)], 1u);
    return b;
}
__device__ __forceinline__ void xcd_barrier_complete(unsigned* bar, unsigned x, unsigned& nloc, unsigned& nx) {
    const unsigned G = gridDim.x * gridDim.y * gridDim.z;
    unsigned sum, cnt, mine, sp = 0u;
    for (;;) {
        sum = 0u; cnt = 0u; mine = 0u;
#pragma unroll
        for (unsigned j = 0; j < 16; ++j) { const unsigned c = xb_ld(&bar[XB_XCNT(j)]); sum += c; cnt += (c > 0u) ? 1u : 0u; mine = (j == x) ? c : mine; }
        if (sum == G) break;
        __builtin_amdgcn_s_sleep(1);
        if ((++sp & 255u) == 0u) { if (xb_ld(&bar[XB_TMO])) break; if (sp > XB_SPIN_CAP) { atomicAdd(&bar[XB_TMO], 1u); break; } }
    }
    nloc = mine > 0u ? mine : 1u; nx = cnt > 0u ? cnt : 1u;
}
__device__ __forceinline__ void xcd_barrier(const XcdBarrier& b) {
    asm volatile("s_waitcnt vmcnt(0)" ::: "memory");
    __syncthreads();
    if (threadIdx.x == 0) {
        unsigned* bar = b.bar;
        __builtin_amdgcn_s_waitcnt(0);
        unsigned nloc = b.st[0], nx = b.st[1];
        if (nloc == 0u) { xcd_barrier_complete(bar, b.x, nloc, nx); b.st[0] = nloc; b.st[1] = nx; }
        const unsigned old = xb_add(&bar[XB_XSUB(b.x)], 1u);
        const unsigned gen = old / nloc;
        if (old + 1u == (gen + 1u) * nloc) {
            __builtin_amdgcn_fence(__ATOMIC_RELEASE, "agent");
            asm volatile("s_waitcnt vmcnt(0)" ::: "memory");
            const unsigned og = xb_add(&bar[XB_TOP], 1u);
            const unsigned tg = og / nx;
            if (og + 1u == (tg + 1u) * nx) xb_add(&bar[XB_TOPGEN], 1u);
            else XB_SPIN(xb_ld(&bar[XB_TOPGEN]) == tg, bar);
            __builtin_amdgcn_fence(__ATOMIC_ACQUIRE, "agent");
            xb_add(&bar[XB_XGEN(b.x)], 1u);
            asm volatile("s_waitcnt vmcnt(0)" ::: "memory");
        } else {
            XB_SPIN(xb_ld(&bar[XB_XGEN(b.x)]) == gen, bar);
            __builtin_amdgcn_fence(__ATOMIC_ACQUIRE, "agent");
            asm volatile("s_waitcnt vmcnt(0)" ::: "memory");
        }
    }
    __syncthreads();
}

enum { I_X = 0, I_P, I_POS, I_GMIX, I_WIN, I_CONVW, I_CONVB, I_DTB, I_ALOG, I_DSKIP, I_GSSD, I_SINKS, I_WATTN, I_WSSD, I_WO, I_GFFN, I_WGATE, I_WUP, I_WDOWN, I_GPLE, I_WPG, I_WPP, I_GFIN, N_IN };
struct Args { const void* in[N_IN]; float* out; unsigned char* ws; int ph_lo, ph_hi; };

__device__ __forceinline__ float wave_sum(float v) {
#pragma unroll
    for (int o = 1; o < 64; o <<= 1) v += __shfl_xor(v, o);
    return v;
}

__device__ __forceinline__ int phys_row(int kind, int n) {
    if (kind == 0) return n;
    if (kind == 1) {
        if (n < 1280) { const int d = n & 63; return (n & ~63) + 2 * (d & 31) + (d >> 5); }
        if (n < 6656) return n;
        if (n < 6688) return 10752 + (n - 6656);
        return n - 32;
    }
    if (kind == 2) return ((n >> 7) << 8) + (n & 127);
    return ((n >> 7) << 8) + 128 + (n & 127);
}
struct P0Desc { const float* W; const float* g; bf16* WT; int K, N, kind, k0, n0; };
__device__ __forceinline__ bool p0_decode(const Args& a, int it, P0Desc& d) {
    unsigned char* ws = a.ws;
    constexpr int I0 = 32 * (NIN / 32), I1 = 16 * 64, I2 = 32 * 64, I3 = 32 * 64, I4 = 32 * (FF / 32), I5 = I4, I6 = (FF / 64) * 64, I7 = 32 * 64, I8 = 4 * 64;
    constexpr int NITEMS = I0 + I1 + I2 + I3 + I4 + I5 + I6 + I7 + I8;
    if (it >= NITEMS) return false;
    int r = it;
    if (r < I0) { d = P0Desc{(const float*)a.in[I_WIN], (const float*)a.in[I_GMIX], (bf16*)(ws + WS_WIN), DM, NIN, 1, 0, 0}; }
    else if ((r -= I0) < I1) { d = P0Desc{(const float*)a.in[I_WATTN], nullptr, (bf16*)(ws + WS_WATTN), QD, DM, 0, 0, 0}; }
    else if ((r -= I1) < I2) { d = P0Desc{(const float*)a.in[I_WSSD], (const float*)a.in[I_GSSD], (bf16*)(ws + WS_WSSD), DI, DM, 0, 0, 0}; }
    else if ((r -= I2) < I3) { d = P0Desc{(const float*)a.in[I_WO], nullptr, (bf16*)(ws + WS_WO), DM, DM, 0, 0, 0}; }
    else if ((r -= I3) < I4) { d = P0Desc{(const float*)a.in[I_WGATE], (const float*)a.in[I_GFFN], (bf16*)(ws + WS_WGU), DM, FF, 2, 0, 0}; }
    else if ((r -= I4) < I5) { d = P0Desc{(const float*)a.in[I_WUP], (const float*)a.in[I_GFFN], (bf16*)(ws + WS_WGU), DM, FF, 3, 0, 0}; }
    else if ((r -= I5) < I6) { d = P0Desc{(const float*)a.in[I_WDOWN], nullptr, (bf16*)(ws + WS_WDOWN), FF, DM, 0, 0, 0}; }
    else if ((r -= I6) < I7) { d = P0Desc{(const float*)a.in[I_WPG], (const float*)a.in[I_GPLE], (bf16*)(ws + WS_WPG), DM, DM, 0, 0, 0}; }
    else { r -= I7; d = P0Desc{(const float*)a.in[I_WPP], nullptr, (bf16*)(ws + WS_WPP), PLE, DM, 0, 0, 0}; }
    const int nblk = d.N / 32; d.k0 = 64 * (r / nblk); d.n0 = 32 * (r % nblk);
    return true;
}
__device__ __forceinline__ void p0_load(const P0Desc& d, int lane, float (&v)[32], f32x4 (&gv)[2]) {
    const GAS float* src = (const GAS float*)d.W + (size_t)(d.k0 + (lane >> 5)) * d.N + d.n0 + (lane & 31);
#pragma unroll
    for (int i = 0; i < 32; ++i) v[i] = src[(size_t)(2 * i) * d.N];
    if (d.g) { gv[0] = *(const GAS f32x4*)(d.g + d.k0 + 8 * (lane & 7)); gv[1] = *(const GAS f32x4*)(d.g + d.k0 + 8 * (lane & 7) + 4); }
    else { gv[0] = (f32x4){1.f, 1.f, 1.f, 1.f}; gv[1] = gv[0]; }
}
__device__ __forceinline__ void p0_finish(const P0Desc& d, LAS float* scr, int lane, const float (&v)[32], const f32x4 (&gv)[2]) {
#pragma unroll
    for (int i = 0; i < 32; ++i) scr[(2 * i + (lane >> 5)) * 33 + (lane & 31)] = v[i];
    LDS_WAIT(); asm volatile("" ::: "memory");
    const int c = lane & 7;
#pragma unroll
    for (int j = 0; j < 4; ++j) { const int n = (lane >> 3) + 8 * j; const LAS float* s = scr + (8 * c) * 33 + n;
        v4u o; o.x = pk_bf16(s[0 * 33] * gv[0][0], s[1 * 33] * gv[0][1]); o.y = pk_bf16(s[2 * 33] * gv[0][2], s[3 * 33] * gv[0][3]);
        o.z = pk_bf16(s[4 * 33] * gv[1][0], s[5 * 33] * gv[1][1]); o.w = pk_bf16(s[6 * 33] * gv[1][2], s[7 * 33] * gv[1][3]);
        *(GAS v4u*)(d.WT + (size_t)phys_row(d.kind, d.n0 + n) * d.K + d.k0 + 8 * c) = o; }
    LDS_WAIT(); asm volatile("" ::: "memory");
}
__device__ __forceinline__ void p0_prologue(const Args& a, LAS unsigned char* lds, int vcu, int G) {
    const int tid = threadIdx.x, lane = tid & 63, wave = __builtin_amdgcn_readfirstlane(tid >> 6);
    unsigned char* ws = a.ws;
    LAS float* scr = (LAS float*)(lds + wave * 16384);
    const int gw = vcu * NWAVES + wave, NGW = G * NWAVES;
    {
        P0Desc dc, dn; float vc[32], vn[32]; f32x4 gc[2], gn[2];
        int it = gw; bool have = p0_decode(a, it, dc);
        if (have) p0_load(dc, lane, vc, gc);
        while (have) {
            const bool hn = p0_decode(a, it + NGW, dn);
            if (hn) p0_load(dn, lane, vn, gn);
            p0_finish(dc, scr, lane, vc, gc);
            if (hn) { dc = dn; gc[0] = gn[0]; gc[1] = gn[1];
#pragma unroll
                for (int i = 0; i < 32; ++i) vc[i] = vn[i]; }
            have = hn; it += NGW;
        }
    }
    const int gt = vcu * NTHREADS + tid, NGT = G * NTHREADS;
    { GAS v4u* z = (GAS v4u*)(ws + WS_WIN + (size_t)NIN * DM * 2); const int nz = (NINP - NIN) * DM * 2 / 16;
      for (int i = gt; i < nz; i += NGT) z[i] = (v4u){0u, 0u, 0u, 0u}; }
    { const float* x = (const float*)a.in[I_X]; bf16* U = (bf16*)(ws + WS_U);
      for (int m = gw; m < M; m += NGW) {
          const GAS f32x4* xr = (const GAS f32x4*)(x + (size_t)m * DM) + lane; f32x4 v[8]; float s = 0.f;
#pragma unroll
          for (int j = 0; j < 8; ++j) { v[j] = xr[64 * j]; s += (v[j][0] * v[j][0] + v[j][1] * v[j][1]) + (v[j][2] * v[j][2] + v[j][3] * v[j][3]); }
          const float r = rsqrtf(wave_sum(s) * (1.f / DM) + 1e-6f);
          GAS v2u* o = (GAS v2u*)(U + (size_t)m * DM) + lane;
#pragma unroll
          for (int j = 0; j < 8; ++j) { v2u w; w.x = pk_bf16(v[j][0] * r, v[j][1] * r); w.y = pk_bf16(v[j][2] * r, v[j][3] * r); o[64 * j] = w; } } }
    { const GAS f32x4* p = (const GAS f32x4*)a.in[I_P]; GAS v4u* o = (GAS v4u*)(ws + WS_PB); const int n8 = M * PLE / 8;
      for (int i = gt; i < n8; i += NGT) { const f32x4 v0 = p[2 * i], v1 = p[2 * i + 1]; v4u w; w.x = pk_bf16(v0[0], v0[1]); w.y = pk_bf16(v0[2], v0[3]); w.z = pk_bf16(v1[0], v1[1]); w.w = pk_bf16(v1[2], v1[3]); o[i] = w; } }
    { const int* pos = (const int*)a.in[I_POS]; float* cs = (float*)(ws + WS_CS);
      for (int i = gt; i < M * 32; i += NGT) { const int tok = i >> 5, fi = i & 31; const float inv = exp2f(-(float)fi * (13.287712379549449f / 32.f));
          const float ang = (float)pos[tok] * inv; float sn, cn; sincosf(ang, &sn, &cn); *(f32x2p*)(cs + 2 * (size_t)i) = (f32x2p){cn, sn}; } }
}

constexpr int KS_PITCH = 72, VT_PITCH = 264;
__device__ __forceinline__ void attn_unit(const Args& a, LAS unsigned char* lds, int unit) {
    const int tid = threadIdx.x, lane = tid & 63, wid = __builtin_amdgcn_readfirstlane(tid >> 6), r32 = lane & 31, hi = lane >> 5;
    const int hk = unit & 3, nb = (unit >> 2) & 15, b = unit >> 6;
    const bf16* Q = (const bf16*)(a.ws + WS_Q); const bf16* K = (const bf16*)(a.ws + WS_K); const bf16* V = (const bf16*)(a.ws + WS_V); bf16* O = (bf16*)(a.ws + WS_ATTN);
    const int tok0 = b * SEQ + nb * 128 - 128;
    LAS bf16* Ks = (LAS bf16*)lds; LAS bf16* VT = (LAS bf16*)(lds + 256 * KS_PITCH * 2);
    {
        const int row = tid >> 1, half = tid & 1; const bool valid = (nb > 0) || (row >= 128);
        v4u kv[4], vv[4];
        if (valid) { const GAS v4u* kp = (const GAS v4u*)(K + (size_t)(tok0 + row) * KVD + hk * 64 + half * 32); const GAS v4u* vp = (const GAS v4u*)(V + (size_t)(tok0 + row) * KVD + hk * 64 + half * 32);
#pragma unroll
            for (int i = 0; i < 4; ++i) { kv[i] = kp[i]; vv[i] = vp[i]; } }
        else {
#pragma unroll
            for (int i = 0; i < 4; ++i) { kv[i] = (v4u){0u, 0u, 0u, 0u}; vv[i] = (v4u){0u, 0u, 0u, 0u}; } }
#pragma unroll
        for (int i = 0; i < 4; ++i) *(LAS v4u*)(Ks + row * KS_PITCH + half * 32 + i * 8) = kv[i];
        const int pos = (row & ~12) | ((row & 4) << 1) | ((row & 8) >> 1);
#pragma unroll
        for (int i = 0; i < 4; ++i)
#pragma unroll
            for (int e = 0; e < 4; ++e) { const unsigned w = vv[i][e]; const int d = half * 32 + 8 * i + 2 * e;
                VT[d * VT_PITCH + pos] = (bf16)(w & 0xffffu); VT[(d + 1) * VT_PITCH + pos] = (bf16)(w >> 16); }
    }
    __syncthreads();
    const int head = hk * 4 + (wid >> 1);
    const float sink2 = ((const float*)a.in[I_SINKS])[head] * LOG2E;
#pragma unroll 1
    for (int qq = 0; qq < 2; ++qq) {
        const int qb = 2 * (wid & 1) + qq, q0 = 32 * qb, qi = q0 + r32;
        const size_t tokq = (size_t)(b * SEQ + nb * 128 + qi);
        bf16x8 qf[4];
#pragma unroll
        for (int ks = 0; ks < 4; ++ks) qf[ks] = *(const GAS bf16x8*)(Q + tokq * QD + head * 64 + 16 * ks + 8 * hi);
        f32x16 S[5];
#pragma unroll
        for (int t = 0; t < 5; ++t) { S[t] = (f32x16){};
#pragma unroll
            for (int ks = 0; ks < 4; ++ks) { const bf16x8 kf = *(const LAS bf16x8*)(Ks + (32 * (qb + t) + r32) * KS_PITCH + 16 * ks + 8 * hi);
                S[t] = __builtin_amdgcn_mfma_f32_32x32x16_bf16(kf, qf[ks], S[t], 0, 0, 0); } }
        float mx = sink2;
#pragma unroll
        for (int t = 0; t < 5; ++t)
#pragma unroll
            for (int r = 0; r < 16; ++r) { const int j = 32 * (qb + t) + (r & 3) + 8 * (r >> 2) + 4 * hi;
                const bool ok = (j > qi) && (j <= qi + 128) && ((nb > 0) || (j >= 128));
                S[t][r] = ok ? S[t][r] : -INFINITY; mx = fmaxf(mx, S[t][r]); }
        mx = fmaxf(mx, __shfl_xor(mx, 32));
        float sum = 0.f;
#pragma unroll
        for (int t = 0; t < 5; ++t)
#pragma unroll
            for (int r = 0; r < 16; ++r) { const float p = __builtin_amdgcn_exp2f(S[t][r] - mx); S[t][r] = p; sum += p; }
        sum += __shfl_xor(sum, 32); sum += __builtin_amdgcn_exp2f(sink2 - mx);
        const float inv = 1.f / sum;
        f32x16 Oa[2]; Oa[0] = (f32x16){}; Oa[1] = (f32x16){};
#pragma unroll
        for (int t = 0; t < 5; ++t)
#pragma unroll
            for (int s2 = 0; s2 < 2; ++s2) { bf16x8 pf; { v4u w; w.x = pk_bf16(S[t][8 * s2 + 0], S[t][8 * s2 + 1]); w.y = pk_bf16(S[t][8 * s2 + 2], S[t][8 * s2 + 3]); w.z = pk_bf16(S[t][8 * s2 + 4], S[t][8 * s2 + 5]); w.w = pk_bf16(S[t][8 * s2 + 6], S[t][8 * s2 + 7]); pf = __builtin_bit_cast(bf16x8, w); }
#pragma unroll
                for (int db = 0; db < 2; ++db) { const bf16x8 vf = *(const LAS bf16x8*)(VT + (32 * db + r32) * VT_PITCH + 32 * (qb + t) + 16 * s2 + 8 * hi);
                    Oa[db] = __builtin_amdgcn_mfma_f32_32x32x16_bf16(vf, pf, Oa[db], 0, 0, 0); } }
#pragma unroll
        for (int db = 0; db < 2; ++db)
#pragma unroll
            for (int rq = 0; rq < 4; ++rq) { v2u w; w.x = pk_bf16(Oa[db][4 * rq] * inv, Oa[db][4 * rq + 1] * inv); w.y = pk_bf16(Oa[db][4 * rq + 2] * inv, Oa[db][4 * rq + 3] * inv);
                *(GAS v2u*)(O + tokq * QD + head * 64 + 32 * db + 8 * rq + 4 * hi) = w; }
    }
    __syncthreads();
}

constexpr int BC_PITCH = 136;
template <bool S1> __device__ __forceinline__ void conv_bc(const Args& a, int t0, bool first, int g, LAS bf16* Bimg, LAS bf16* Cimg) {
    const int tid = threadIdx.x, cp = tid & 127, tq = tid >> 7;
    if (S1 && cp >= 64) return;
    const bf16* xbc = (const bf16*)(a.ws + WS_XBC); const float* cw = (const float*)a.in[I_CONVW]; const float* cb = (const float*)a.in[I_CONVB];
    const int chan = (cp < 64) ? (2048 + 128 * g + 2 * cp) : (2560 + 128 * g + 2 * (cp - 64));
    float w[4][2], bias[2];
#pragma unroll
    for (int k = 0; k < 4; ++k) { w[k][0] = cw[k * CONVD + chan]; w[k][1] = cw[k * CONVD + chan + 1]; }
    bias[0] = cb[chan]; bias[1] = cb[chan + 1];
    const int l0 = 32 * tq;
    unsigned xin[35];
#pragma unroll
    for (int i = 0; i < 35; ++i) { const int l = l0 - 3 + i; xin[i] = (first && l < 0) ? 0u : *(const GAS unsigned*)(xbc + (size_t)(t0 + l) * CONVD + chan); }
#pragma unroll
    for (int l = 0; l < 32; ++l) {
        float o0 = bias[0], o1 = bias[1];
#pragma unroll
        for (int k = 0; k < 4; ++k) { o0 += w[k][0] * bf_lo(xin[l + k]); o1 += w[k][1] * bf_hi(xin[l + k]); }
        o0 = silu_f(o0); o1 = silu_f(o1);
        if (S1) { const unsigned pk = pk_bf16(o0, o1); Bimg[(2 * cp) * BC_PITCH + l0 + l] = (bf16)(pk & 0xffffu); Bimg[(2 * cp + 1) * BC_PITCH + l0 + l] = (bf16)(pk >> 16); }
        else { LAS bf16* img = (cp < 64) ? Bimg : Cimg; *(LAS unsigned*)(img + (l0 + l) * BC_PITCH + 2 * (cp & 63)) = pk_bf16(o0, o1); }
    }
}
template <int NT> __device__ __forceinline__ void conv_x(const bf16* xcol  , int l, bool first, const float (&w)[4], float bias, float (&out)[NT]) {
    float xin[NT + 3];
#pragma unroll
    for (int i = 0; i < NT + 3; ++i) { const int ll = l - 3 + i; xin[i] = (first && ll < 0) ? 0.f : bf2f(*(const GAS bf16*)(xcol + (ptrdiff_t)ll * CONVD)); }
#pragma unroll
    for (int j = 0; j < NT; ++j) out[j] = silu_f(bias + w[0] * xin[j] + w[1] * xin[j + 1] + w[2] * xin[j + 2] + w[3] * xin[j + 3]);
}

__device__ __forceinline__ void ssd_states_unit(const Args& a, LAS unsigned char* lds, int unit) {
    const int tid = threadIdx.x, lane = tid & 63, wid = __builtin_amdgcn_readfirstlane(tid >> 6), r32 = lane & 31, hi = lane >> 5;
    const int g = unit & 3, c = (unit >> 2) & 15, b = unit >> 6, t0 = b * SEQ + c * 128; const bool first = (c == 0);
    LAS bf16* BT = (LAS bf16*)lds; LAS float* wv = (LAS float*)(lds + 128 * BC_PITCH * 2) + wid * 128;
    conv_bc<true>(a, t0, first, g, BT, nullptr);
    const int hh = 8 * g + wid;
    const float* dtp = (const float*)(a.ws + WS_DT); float* acsg = (float*)(a.ws + WS_ACS);
    const float aneg = -expf(((const float*)a.in[I_ALOG])[hh]);
    {
        const float d0 = dtp[(size_t)(t0 + lane) * NH + hh], d1 = dtp[(size_t)(t0 + 64 + lane) * NH + hh];
        float c0 = d0 * aneg, c1 = d1 * aneg;
#pragma unroll
        for (int o = 1; o < 64; o <<= 1) { const float u0 = __shfl_up(c0, o), u1 = __shfl_up(c1, o); if (lane >= o) { c0 += u0; c1 += u1; } }
        c1 += __shfl(c0, 63); const float tot = __shfl(c1, 63);
        acsg[(size_t)(t0 + lane) * NH + hh] = c0; acsg[(size_t)(t0 + 64 + lane) * NH + hh] = c1;
        wv[lane] = d0 * expf(tot - c0); wv[lane + 64] = d1 * expf(tot - c1);
    }
    __syncthreads();
    const bf16* xbc = (const bf16*)(a.ws + WS_XBC); const float* cw = (const float*)a.in[I_CONVW]; const float* cb = (const float*)a.in[I_CONVB];
    float* st = (float*)(a.ws + WS_STATES) + (size_t)((b * NCH + c) * NH + hh) * 8192;
#pragma unroll 1
    for (int pb = 0; pb < 2; ++pb) {
        const int ch = hh * 64 + 32 * pb + r32;
        float w[4]; for (int k = 0; k < 4; ++k) w[k] = cw[k * CONVD + ch]; const float bias = cb[ch];
        const bf16* xcol = xbc + (size_t)t0 * CONVD + ch;
        f32x16 acc[4]; for (int i = 0; i < 4; ++i) acc[i] = (f32x16){};
#pragma unroll 2
        for (int ks = 0; ks < 8; ++ks) {
            const int lb = 16 * ks + 8 * hi; float xv[8]; conv_x<8>(xcol, lb, first, w, bias, xv);
            const f32x4 w0 = *(const LAS f32x4*)(wv + lb), w1 = *(const LAS f32x4*)(wv + lb + 4);
            v4u pw; pw.x = pk_bf16(xv[0] * w0[0], xv[1] * w0[1]); pw.y = pk_bf16(xv[2] * w0[2], xv[3] * w0[3]); pw.z = pk_bf16(xv[4] * w1[0], xv[5] * w1[1]); pw.w = pk_bf16(xv[6] * w1[2], xv[7] * w1[3]);
            const bf16x8 bfr = __builtin_bit_cast(bf16x8, pw);
#pragma unroll
            for (int nb = 0; nb < 4; ++nb) { const bf16x8 af = *(const LAS bf16x8*)(BT + (32 * nb + r32) * BC_PITCH + lb); acc[nb] = __builtin_amdgcn_mfma_f32_32x32x16_bf16(af, bfr, acc[nb], 0, 0, 0); }
        }
#pragma unroll
        for (int nb = 0; nb < 4; ++nb)
#pragma unroll
            for (int rq = 0; rq < 4; ++rq) *(GAS f32x4*)(st + (size_t)(32 * pb + r32) * 128 + 32 * nb + 8 * rq + 4 * hi) = (f32x4){acc[nb][4 * rq], acc[nb][4 * rq + 1], acc[nb][4 * rq + 2], acc[nb][4 * rq + 3]};
    }
    __syncthreads();
}

__device__ __forceinline__ void ssd_scan(const Args& a, int vcu, int G) {
    const float* st = (const float*)(a.ws + WS_STATES); bf16* prev = (bf16*)(a.ws + WS_PREV); const float* acsg = (const float*)(a.ws + WS_ACS);
    const int gt = vcu * NTHREADS + threadIdx.x, NGT = G * NTHREADS;
    for (int i = gt; i < BATCH * NH * 2048; i += NGT) {
        const int e4 = i & 2047, hh = (i >> 11) & 31, b = i >> 16;
        f32x4 carry = (f32x4){0.f, 0.f, 0.f, 0.f};
#pragma unroll 4
        for (int c = 0; c < NCH; ++c) { const size_t off = (size_t)((b * NCH + c) * NH + hh) * 8192 + 4 * e4;
            const f32x4 s = *(const GAS f32x4*)(st + off); const float dec = expf(acsg[(size_t)(b * SEQ + c * 128 + 127) * NH + hh]);
            v2u w; w.x = pk_bf16(carry[0], carry[1]); w.y = pk_bf16(carry[2], carry[3]); *(GAS v2u*)(prev + off) = w;
            carry = carry * dec + s; }
    }
}

constexpr int S3_XF = 2 * 128 * BC_PITCH * 2, S3_TAB = S3_XF + 4 * 16384, S3_SSQ = S3_TAB + 4 * 1024, S3_END = S3_SSQ + 4 * 128 * 4;
__device__ __forceinline__ void ssd_out_unit(const Args& a, LAS unsigned char* lds, int unit) {
    const int tid = threadIdx.x, lane = tid & 63, wid = __builtin_amdgcn_readfirstlane(tid >> 6), r32 = lane & 31, hi = lane >> 5;
    const int hhalf = unit & 1, g = (unit >> 1) & 3, c = (unit >> 3) & 15, b = unit >> 7, t0 = b * SEQ + c * 128; const bool first = (c == 0);
    const int hl = wid >> 1, role = wid & 1, hh = 8 * g + 4 * hhalf + hl;
    LAS bf16* Bs = (LAS bf16*)lds; LAS bf16* Cs = Bs + 128 * BC_PITCH;
    LAS unsigned char* XF = lds + S3_XF + hl * 16384;
    LAS float* acsw = (LAS float*)(lds + S3_TAB) + hl * 256; LAS float* dtw = acsw + 128;
    LAS float* ssqx = (LAS float*)(lds + S3_SSQ);
    conv_bc<false>(a, t0, first, g, Bs, Cs);
    { const float* dtp = (const float*)(a.ws + WS_DT); const float* acsg = (const float*)(a.ws + WS_ACS); const int l = lane + 64 * role;
      acsw[l] = acsg[(size_t)(t0 + l) * NH + hh]; dtw[l] = dtp[(size_t)(t0 + l) * NH + hh]; }
    {
        const bf16* xbc = (const bf16*)(a.ws + WS_XBC); const float* cw = (const float*)a.in[I_CONVW]; const float* cb = (const float*)a.in[I_CONVB];
        const int ch = hh * 64 + 32 * role + r32;
        float w[4]; for (int k = 0; k < 4; ++k) w[k] = cw[k * CONVD + ch]; const float bias = cb[ch];
        const bf16* xcol = xbc + (size_t)t0 * CONVD + ch;
#pragma unroll
        for (int sb = 0; sb < 4; ++sb) {
#pragma unroll
            for (int s2 = 0; s2 < 2; ++s2) { const int l = 32 * sb + 16 * s2 + 4 * hi; float x0[4], x1[4]; conv_x<4>(xcol, l, first, w, bias, x0); conv_x<4>(xcol, l + 8, false, w, bias, x1);
                v4u pw; pw.x = pk_bf16(x0[0], x0[1]); pw.y = pk_bf16(x0[2], x0[3]); pw.z = pk_bf16(x1[0], x1[1]); pw.w = pk_bf16(x1[2], x1[3]);
                *(LAS v4u*)(XF + ((role * 4 + sb) * 2 + s2) * 1024 + lane * 16) = pw; }
            if (sb & 1) asm volatile("" ::: "memory"); }
    }
    __syncthreads();
    const float Dh = ((const float*)a.in[I_DSKIP])[hh];
    const bf16* prev = (const bf16*)(a.ws + WS_PREV) + (size_t)((b * NCH + c) * NH + hh) * 8192;
    const bf16* sz = (const bf16*)(a.ws + WS_SZ); bf16* yp = (bf16*)(a.ws + WS_YP);
#pragma unroll 1
    for (int it = 0; it < 2; ++it) {
        const int lb = role ? 1 + it : 3 * it;
        const int l = 32 * lb + r32; const float acs_l = acsw[l];
        bf16x8 Cf[8];
#pragma unroll
        for (int ks = 0; ks < 8; ++ks) Cf[ks] = *(const LAS bf16x8*)(Cs + l * BC_PITCH + 16 * ks + 8 * hi);
        f32x16 Y[2]; Y[0] = (f32x16){}; Y[1] = (f32x16){};
        if (!first) {
#pragma unroll
            for (int ks = 0; ks < 8; ++ks)
#pragma unroll
                for (int pb = 0; pb < 2; ++pb) { const bf16x8 pf = *(const GAS bf16x8*)(prev + (size_t)(32 * pb + r32) * 128 + 16 * ks + 8 * hi); Y[pb] = __builtin_amdgcn_mfma_f32_32x32x16_bf16(pf, Cf[ks], Y[pb], 0, 0, 0); }
            const float el = __builtin_amdgcn_exp2f(acs_l * LOG2E);
            Y[0] = Y[0] * el; Y[1] = Y[1] * el;
        }
#pragma unroll 1
        for (int sb = 0; sb <= lb; ++sb) {
            f32x16 cbt = (f32x16){};
#pragma unroll
            for (int ks = 0; ks < 8; ++ks) { const bf16x8 bfr = *(const LAS bf16x8*)(Bs + (32 * sb + r32) * BC_PITCH + 16 * ks + 8 * hi); cbt = __builtin_amdgcn_mfma_f32_32x32x16_bf16(bfr, Cf[ks], cbt, 0, 0, 0); }
            float gv[16];
#pragma unroll
            for (int rq = 0; rq < 4; ++rq) { const int s0 = 32 * sb + 8 * rq + 4 * hi; const f32x4 as = *(const LAS f32x4*)(acsw + s0), ds = *(const LAS f32x4*)(dtw + s0);
#pragma unroll
                for (int e = 0; e < 4; ++e) { float v = cbt[4 * rq + e] * ds[e] * __builtin_amdgcn_exp2f((acs_l - as[e]) * LOG2E);
                    const int s = s0 + e; v = (s > l) ? 0.f : v; v = (s == l) ? v + Dh : v;
                    gv[4 * rq + e] = v; } }
#pragma unroll
            for (int s2 = 0; s2 < 2; ++s2) { v4u pw; pw.x = pk_bf16(gv[8 * s2 + 0], gv[8 * s2 + 1]); pw.y = pk_bf16(gv[8 * s2 + 2], gv[8 * s2 + 3]); pw.z = pk_bf16(gv[8 * s2 + 4], gv[8 * s2 + 5]); pw.w = pk_bf16(gv[8 * s2 + 6], gv[8 * s2 + 7]);
                const bf16x8 gf = __builtin_bit_cast(bf16x8, pw);
                const bf16x8 x0 = *(const LAS bf16x8*)(XF + ((0 * 4 + sb) * 2 + s2) * 1024 + lane * 16), x1 = *(const LAS bf16x8*)(XF + ((1 * 4 + sb) * 2 + s2) * 1024 + lane * 16);
                Y[0] = __builtin_amdgcn_mfma_f32_32x32x16_bf16(x0, gf, Y[0], 0, 0, 0); Y[1] = __builtin_amdgcn_mfma_f32_32x32x16_bf16(x1, gf, Y[1], 0, 0, 0); }
        }
        const size_t tok = (size_t)(t0 + l); float ssq = 0.f;
#pragma unroll
        for (int pb = 0; pb < 2; ++pb)
#pragma unroll
            for (int rq = 0; rq < 4; ++rq) { const size_t off = tok * DI + hh * 64 + 32 * pb + 8 * rq + 4 * hi; const v2u zz = *(const GAS v2u*)(sz + off);
                const float y0 = Y[pb][4 * rq] * bf_lo(zz.x), y1 = Y[pb][4 * rq + 1] * bf_hi(zz.x), y2 = Y[pb][4 * rq + 2] * bf_lo(zz.y), y3 = Y[pb][4 * rq + 3] * bf_hi(zz.y);
                ssq += (y0 * y0 + y1 * y1) + (y2 * y2 + y3 * y3);
                v2u w; w.x = pk_bf16(y0, y1); w.y = pk_bf16(y2, y3); *(GAS v2u*)(yp + off) = w; }
        ssq += __shfl_xor(ssq, 32);
        if (hi == 0) ssqx[hl * 128 + l] = ssq;
    }
    __syncthreads();
    if (tid < 128) { const float s = (ssqx[tid] + ssqx[128 + tid]) + (ssqx[256 + tid] + ssqx[384 + tid]);
        ((float*)(a.ws + WS_SSQ))[(size_t)(t0 + tid) * 8 + 2 * g + hhalf] = s; }
    __syncthreads();
}

__device__ __forceinline__ void final_norm(const Args& a, int vcu, int G) {
    const int tid = threadIdx.x, lane = tid & 63, wave = tid >> 6; const int gw = vcu * NWAVES + wave, NGW = G * NWAVES;
    const float* ss3 = (const float*)(a.ws + WS_SS3); const GAS f32x4* gf = (const GAS f32x4*)a.in[I_GFIN] + lane;
    for (int m = gw; m < M; m += NGW) {
        const f32x4 s0 = *(const GAS f32x4*)(ss3 + (size_t)m * 8), s1 = *(const GAS f32x4*)(ss3 + (size_t)m * 8 + 4);
        const float r = rsqrtf((((s0[0] + s0[1]) + (s0[2] + s0[3])) + ((s1[0] + s1[1]) + (s1[2] + s1[3]))) * (1.f / DM) + 1e-6f);
        GAS f32x4* o = (GAS f32x4*)(a.out + (size_t)m * DM) + lane;
#pragma unroll
        for (int j = 0; j < 8; ++j) { f32x4 v = o[64 * j]; const f32x4 gg = gf[64 * j]; v = v * gg * r; o[64 * j] = v; }
    }
}

__global__ void __launch_bounds__(NTHREADS, 2) mk_fwd(Args args) {
    extern __shared__ __attribute__((aligned(16))) unsigned char lds_raw[];
    LAS unsigned char* lds = (LAS unsigned char*)lds_raw;
    volatile LAS unsigned* MISC = (volatile LAS unsigned*)(lds + MISC_OFF);
    const int tid = threadIdx.x;
    const int G = gridDim.x; const int bx = blockIdx.x; const int vcu = (G % 8 == 0) ? (bx % 8) * (G / 8) + bx / 8 : bx;
    unsigned char* ws = args.ws;
    for (int u = tid; u < 64; u += NTHREADS) MISC[u] = 0u;
    __syncthreads();
    XcdBarrier bar; bar.bar = (unsigned*)(ws + WS_CTL) + CW_BAR; bar.x = 0; bar.st = nullptr;
    if (MK_N_LAUNCHES == 1) bar = xcd_barrier_post((unsigned*)(ws + WS_CTL) + CW_BAR, MISC + 8);
    const int lo = args.ph_lo, hi = args.ph_hi;
    if (lo < 0) cg::this_grid().sync();
#ifndef PHMASK
#define PHMASK 0x7ff
#endif
#define IN(k) (((PHMASK >> (k)) & 1) && lo <= (k) && (k) < hi)
#ifndef REP_MASK
#define REP_MASK 0
#endif
#define PHASE(k) for (int rep_ = 0; rep_ < (IN(k) ? 1 + ((REP_MASK >> (k)) & 1) : 0); ++rep_) if (rep_ > 0 ? (xcd_barrier(bar), true) : true)
#define SEAM(k) do { if (IN(k) && IN((k) + 1)) xcd_barrier(bar); } while (0)
    using pg8::Gemm; using pg8::StaticOrder; using pg8::gemm_phase; using pg8::EpiProj; using pg8::EpiGateA; using pg8::EpiGateS; using pg8::EpiRes; using pg8::EpiGU; using pg8::EpiF32; using pg8::bf16_t;
    PG8_LAS unsigned char* ring = (PG8_LAS unsigned char*)lds;
    PG8_LAS float* xl = (PG8_LAS float*)(lds + XLDS_OFF);

    PHASE(0) { p0_prologue(args, lds, vcu, G); }
    SEAM(0);
    PHASE(1) {
        Gemm g{(const bf16_t*)(ws + WS_U), (const bf16_t*)(ws + WS_WIN), M, NINP, DM}; StaticOrder S; S.init(M, NINP, G, bx);
        EpiProj E{(bf16_t*)(ws + WS_Q), (bf16_t*)(ws + WS_K), (bf16_t*)(ws + WS_V), (bf16_t*)(ws + WS_SZ), (bf16_t*)(ws + WS_XBC), (bf16_t*)args.out, (bf16_t*)args.out + (size_t)M * DM,
                  (float*)(ws + WS_DT), (const float*)(ws + WS_CS), (const float*)args.in[I_DTB]};
        gemm_phase<EpiProj, StaticOrder, true, true>(ring, g, S, E);
    }
    SEAM(1);
    PHASE(2) {
        for (int u = vcu; u < BATCH * NCH * 4; u += G) attn_unit(args, lds, u);
        for (int u = vcu; u < BATCH * NCH * 4; u += G) ssd_states_unit(args, lds, u);
    }
    SEAM(2);
    PHASE(3) { ssd_scan(args, vcu, G); }
    SEAM(3);
    PHASE(4) { static_assert(S3_END <= MISC_OFF, "S3 LDS"); for (int u = vcu; u < BATCH * NCH * 8; u += G) ssd_out_unit(args, lds, u); }
    SEAM(4);
    PHASE(5) {
        { Gemm g{(const bf16_t*)(ws + WS_ATTN), (const bf16_t*)(ws + WS_WATTN), M, DM, QD}; StaticOrder S; S.init(M, DM, G, bx);
          EpiGateA E{(const bf16_t*)args.out, (float*)(ws + WS_TMP)};
          gemm_phase<EpiGateA, StaticOrder, true, true>(ring, g, S, E); }
        { Gemm g{(const bf16_t*)(ws + WS_YP), (const bf16_t*)(ws + WS_WSSD), M, DM, DI}; StaticOrder S; S.init(M, DM, G, bx);
          EpiGateS E{(const bf16_t*)args.out + (size_t)M * DM, (const float*)(ws + WS_TMP), (const float*)(ws + WS_SSQ), (bf16_t*)(ws + WS_MERGED)};
          gemm_phase<EpiGateS, StaticOrder, true, true>(ring, g, S, E); }
    }
    SEAM(5);
    PHASE(6) {
        Gemm g{(const bf16_t*)(ws + WS_MERGED), (const bf16_t*)(ws + WS_WO), M, DM, DM}; StaticOrder S; S.init(M, DM, G, bx);
        EpiRes<0> E{(const float*)args.in[I_X], args.out, (bf16_t*)(ws + WS_H1B), (float*)(ws + WS_SS1), nullptr, nullptr, xl, 0.f};
        gemm_phase<EpiRes<0>, StaticOrder, true, true>(ring, g, S, E);
    }
    SEAM(6);
    PHASE(7) {
        Gemm g{(const bf16_t*)(ws + WS_H1B), (const bf16_t*)(ws + WS_WGU), M, 2 * FF, DM}; StaticOrder S; S.init(M, 2 * FF, G, bx);
        EpiGU E{(const float*)(ws + WS_SS1), (bf16_t*)(ws + WS_ACT), 1e-6f};
        gemm_phase<EpiGU, StaticOrder, true, true>(ring, g, S, E);
    }
    SEAM(7);
    PHASE(8) {
        Gemm g{(const bf16_t*)(ws + WS_ACT), (const bf16_t*)(ws + WS_WDOWN), M, DM, FF}; StaticOrder S; S.init(M, DM, G, bx);
        EpiRes<0> E{args.out, args.out, (bf16_t*)(ws + WS_H2B), (float*)(ws + WS_SS2), nullptr, nullptr, xl, 0.f};
        gemm_phase<EpiRes<0>, StaticOrder, true, true>(ring, g, S, E);
    }
    SEAM(8);
    PHASE(9) {
        { int kp = PLE; asm volatile("" : "+s"(kp));
          Gemm g{(const bf16_t*)(ws + WS_PB), (const bf16_t*)(ws + WS_WPP), M, DM, kp}; StaticOrder S; S.init(M, DM, G, bx);
          EpiF32 E{(float*)(ws + WS_TMP)};
          gemm_phase<EpiF32, StaticOrder, true, true>(ring, g, S, E); }
        { Gemm g{(const bf16_t*)(ws + WS_H2B), (const bf16_t*)(ws + WS_WPG), M, DM, DM}; StaticOrder S; S.init(M, DM, G, bx);
          EpiRes<1> E{args.out, args.out, nullptr, (float*)(ws + WS_SS3), (const float*)(ws + WS_SS2), (const float*)(ws + WS_TMP), xl, 1e-6f};
          gemm_phase<EpiRes<1>, StaticOrder, true, true>(ring, g, S, E); }
    }
    SEAM(9);
    PHASE(10) { final_norm(args, vcu, G); }
#undef IN
#undef SEAM
}

extern "C" void kernel_launch(void* const* d_in, const int* in_sizes, int n_in, void* d_out, int out_size, void* d_ws, size_t ws_size, hipStream_t stream) {
    static int grid = 0;
    if (grid == 0) {
        if (n_in != N_IN || in_sizes[0] != M * DM || out_size != M * DM || ws_size < WS_END) {
            fprintf(stderr, "kernel_launch: shape/workspace mismatch (n_in %d, in0 %d, out %d, ws %zu, need %zu); nothing launched\n", n_in, n_in > 0 ? in_sizes[0] : -1, out_size, ws_size, (size_t)WS_END); grid = -1; return; }
        int dev = 0, cus = 0, per_cu = 0;
        hipGetDevice(&dev); hipDeviceGetAttribute(&cus, hipDeviceAttributeMultiprocessorCount, dev);
        if (hipFuncSetAttribute((const void*)mk_fwd, hipFuncAttributeMaxDynamicSharedMemorySize, LDS_BYTES) != hipSuccess) { fprintf(stderr, "kernel_launch: hipFuncSetAttribute failed\n"); grid = -1; return; }
        if (hipOccupancyMaxActiveBlocksPerMultiprocessor(&per_cu, (const void*)mk_fwd, NTHREADS, LDS_BYTES) != hipSuccess || per_cu < 1) { fprintf(stderr, "kernel_launch: occupancy query failed (%d)\n", per_cu); (void)hipGetLastError(); per_cu = 1; }
        grid = cus * (per_cu >= 1 ? 1 : 1);
        fprintf(stderr, "kernel_launch: cus %d per_cu %d grid %d ws %zu\n", cus, per_cu, grid, ws_size);
    }
    if (grid < 0) return;
    hipMemsetAsync((char*)d_ws + WS_CTL, 0, CTL_ZERO_BYTES, stream);
    Args a{};
    for (int i = 0; i < N_IN; ++i) a.in[i] = d_in[i];
    a.out = (float*)d_out; a.ws = (unsigned char*)d_ws;
#if MK_N_LAUNCHES == 1
    a.ph_lo = 0; a.ph_hi = NPHASE;
    void* kargs[] = {&a};
    hipError_t e = hipLaunchCooperativeKernel((const void*)mk_fwd, dim3(grid), dim3(NTHREADS), kargs, LDS_BYTES, stream);
    if (e != hipSuccess) fprintf(stderr, "kernel_launch: cooperative launch failed: %s (grid %d)\n", hipGetErrorString(e), grid);
#else
    for (int ph = 0; ph < NPHASE; ++ph) { a.ph_lo = ph; a.ph_hi = ph + 1; hipLaunchKernelGGL(mk_fwd, dim3(grid), dim3(NTHREADS), LDS_BYTES, stream, a); }
#endif
}
```
